# Optimizing an MI355X kernel written in HIP

```python
import jax, jax.numpy as jnp
from jax import lax
import numpy as np

D_MODEL = 1024
BATCH = 4
SEQ = 4096
DEPTH = 2

D_MIX = D_MODEL
NSA_HEADS = 8
NSA_KV_GROUPS = 2
NSA_HEAD_DIM = 64
NSA_REP = NSA_HEADS // NSA_KV_GROUPS
CMP_BLOCK = 32
CMP_STRIDE = 16
CMP_HIDDEN = 128
SEL_BLOCK = 64
SEL_TOPN = 16
WINDOW = 512
Q_BLOCK = 128
HG_HEADS = 4
HG_DK = 128
HG_DV = 128
HG_CHUNK = 64
D_FF = 2816
ROPE_THETA = 10000.0
EPS = 1e-6
NEG = -1e30

NSA_Q_COLS = NSA_HEADS * NSA_HEAD_DIM
NSA_KV_COLS = NSA_KV_GROUPS * NSA_HEAD_DIM
NSA_GATE_COLS = 3 * NSA_HEADS
HG_K_COLS = HG_HEADS * HG_DK
HG_V_COLS = HG_HEADS * HG_DV
N_IN = NSA_Q_COLS + 6 * NSA_KV_COLS + NSA_GATE_COLS + 2 * HG_K_COLS + 2 * HG_V_COLS

kernel_name = "nsa_hgrn2_macaron_hybrid"


def rmsnorm(x, g):
    xf = x.astype(jnp.float32)
    y = xf * lax.rsqrt(jnp.mean(xf * xf, axis=-1, keepdims=True) + EPS) * g.astype(jnp.float32)
    return y.astype(x.dtype)


def swiglu(x, w_gate, w_up, w_down):
    return (jax.nn.silu(x @ w_gate) * (x @ w_up)) @ w_down


def rope_tables(seq, dim):
    inv = 1.0 / (ROPE_THETA ** (jnp.arange(0, dim, 2, dtype=jnp.float32) / dim))
    ang = jnp.arange(seq, dtype=jnp.float32)[:, None] * inv[None, :]
    ang = jnp.concatenate([ang, ang], axis=-1)
    return jnp.cos(ang), jnp.sin(ang)


def norm_rope(x, g, cos, sin):
    xf = x.astype(jnp.float32)
    xf = xf * lax.rsqrt(jnp.mean(xf * xf, axis=-1, keepdims=True) + EPS) * g.astype(jnp.float32)
    half = xf.shape[-1] // 2
    rot = jnp.concatenate([-xf[..., half:], xf[..., :half]], axis=-1)
    y = xf * cos[None, :, None, :] + rot * sin[None, :, None, :]
    return y.astype(x.dtype)


def compress(t, idx, pos, w1, w2):
    blk = t[:, idx] + pos[None, None, :, None, :].astype(t.dtype)
    h = jax.nn.gelu(jnp.einsum("bnlgd,lde->bnge", blk, w1))
    return jnp.einsum("bnge,ed->bngd", h, w2)


def nsa_group(q, k_cmp, v_cmp, k_sel, v_sel, k_win, v_win, gates, cos, sin,
              q_gain, k_gain, cmp_pos, cmp_w1, cmp_w2):
    B, S = q.shape[0], q.shape[1]
    G, R, dh = NSA_KV_GROUPS, NSA_REP, NSA_HEAD_DIM
    dt = q.dtype
    scale = dh ** -0.5
    q = norm_rope(q, q_gain, cos, sin)
    kc = norm_rope(k_cmp, k_gain[0], cos, sin)
    ks = norm_rope(k_sel, k_gain[1], cos, sin)
    kw = norm_rope(k_win, k_gain[2], cos, sin)

    ncb = (S - CMP_BLOCK) // CMP_STRIDE + 1
    idx = jnp.arange(ncb)[:, None] * CMP_STRIDE + jnp.arange(CMP_BLOCK)[None, :]
    kc_c = compress(kc, idx, cmp_pos[0], cmp_w1[0], cmp_w2[0])
    vc_c = compress(v_cmp, idx, cmp_pos[1], cmp_w1[1], cmp_w2[1])
    cmp_end = jnp.arange(ncb) * CMP_STRIDE + CMP_BLOCK - 1

    nsb = S // SEL_BLOCK
    n_sel = min(SEL_TOPN, nsb)
    ks_blk = ks.reshape(B, nsb, SEL_BLOCK, G, dh).transpose(0, 3, 1, 2, 4)
    vs_blk = v_sel.reshape(B, nsb, SEL_BLOCK, G, dh).transpose(0, 3, 1, 2, 4)
    ci = jnp.arange(ncb)[:, None]
    sj = jnp.arange(nsb)[None, :]
    overlap = ((ci * CMP_STRIDE <= sj * SEL_BLOCK + SEL_BLOCK - 1)
               & (ci * CMP_STRIDE + CMP_BLOCK - 1 >= sj * SEL_BLOCK)).astype(jnp.float32)

    kw_pad = jnp.pad(kw, ((0, 0), (WINDOW, 0), (0, 0), (0, 0)))
    vw_pad = jnp.pad(v_win, ((0, 0), (WINDOW, 0), (0, 0), (0, 0)))
    bi = jnp.arange(B)[:, None, None, None]
    gi = jnp.arange(G)[None, :, None, None]
    jblk = jnp.arange(nsb)

    def block_fn(bq):
        start = bq * Q_BLOCK
        t = start + jnp.arange(Q_BLOCK)
        qb = lax.dynamic_slice_in_dim(q, start, Q_BLOCK, axis=1).reshape(B, Q_BLOCK, G, R, dh)
        gb = lax.dynamic_slice_in_dim(gates, start, Q_BLOCK, axis=1).reshape(B, Q_BLOCK, G, R, 3)

        s1 = jnp.einsum("bqgrd,bngd->bgrqn", qb, kc_c).astype(jnp.float32) * scale
        m1 = cmp_end[None, :] <= t[:, None]
        p1 = jnp.where(m1, jax.nn.softmax(jnp.where(m1, s1, NEG), axis=-1), 0.0)
        o_c = jnp.einsum("bgrqn,bngd->bqgrd", p1.astype(dt), vc_c)

        imp = jnp.einsum("bgrqn,nj->bgqj", p1, overlap)
        cur = t // SEL_BLOCK
        forced = (jblk[None, :] == 0) | (jblk[None, :] == cur[:, None]) | (jblk[None, :] == cur[:, None] - 1)
        valid = jblk[None, :] * SEL_BLOCK <= t[:, None]
        imp = jnp.where(valid, jnp.where(forced, jnp.inf, imp), -jnp.inf)
        _, sel = lax.top_k(imp, n_sel)
        kg = ks_blk[bi, gi, sel]
        vg = vs_blk[bi, gi, sel]
        s2 = jnp.einsum("bqgrd,bgqnld->bgrqnl", qb, kg).astype(jnp.float32) * scale
        kpos = sel[..., None] * SEL_BLOCK + jnp.arange(SEL_BLOCK)
        m2 = (kpos <= t[None, None, :, None, None])[:, :, None]
        s2 = jnp.where(m2, s2, NEG)
        p2 = jax.nn.softmax(s2.reshape(s2.shape[:4] + (-1,)), axis=-1).reshape(s2.shape)
        o_s = jnp.einsum("bgrqnl,bgqnld->bqgrd", p2.astype(dt), vg)

        kwb = lax.dynamic_slice_in_dim(kw_pad, start, Q_BLOCK + WINDOW, axis=1)
        vwb = lax.dynamic_slice_in_dim(vw_pad, start, Q_BLOCK + WINDOW, axis=1)
        kp = start - WINDOW + jnp.arange(Q_BLOCK + WINDOW)
        diff = t[:, None] - kp[None, :]
        m3 = (diff >= 0) & (diff < WINDOW) & (kp[None, :] >= 0)
        s3 = jnp.einsum("bqgrd,bkgd->bgrqk", qb, kwb).astype(jnp.float32) * scale
        p3 = jax.nn.softmax(jnp.where(m3, s3, NEG), axis=-1)
        o_w = jnp.einsum("bgrqk,bkgd->bqgrd", p3.astype(dt), vwb)

        o = gb[..., 0:1] * o_c + gb[..., 1:2] * o_s + gb[..., 2:3] * o_w
        return o.reshape(B, Q_BLOCK, NSA_HEADS * dh)

    out = lax.map(block_fn, jnp.arange(S // Q_BLOCK))
    return out.transpose(1, 0, 2, 3).reshape(B, S, NSA_HEADS * dh)


def hgrn2_group(hq, hf, hi, hg, lb, out_gain):
    B, S = hq.shape[0], hq.shape[1]
    H, dk, dv, C = HG_HEADS, HG_DK, HG_DV, S // HG_CHUNK
    dt = hq.dtype
    q = jax.nn.silu(hq.astype(jnp.float32)).reshape(B, S, H, dk)
    f = lb[None, None] + (1.0 - lb[None, None]) * jax.nn.sigmoid(hf.astype(jnp.float32).reshape(B, S, H, dk))
    logf = jnp.log(jnp.maximum(f, 1e-30))
    k = 1.0 - f
    v = hi.astype(jnp.float32).reshape(B, S, H, dv)

    def to_chunks(a):
        return a.reshape(B, C, HG_CHUNK, H, a.shape[-1]).transpose(1, 0, 3, 2, 4)

    tri = jnp.tril(jnp.ones((HG_CHUNK, HG_CHUNK), dtype=bool))

    def step(state, xs):
        qc, kc, vc, lfc = xs
        b = jnp.cumsum(lfc, axis=-2)
        decay = jnp.exp(jnp.where(tri[:, :, None], b[..., :, None, :] - b[..., None, :, :], -jnp.inf))
        a = jnp.einsum("bhtk,bhtsk,bhsk->bhts", qc, decay, kc)
        o = jnp.einsum("bhts,bhsv->bhtv", a, vc) + jnp.einsum("bhtk,bhkv->bhtv", qc * jnp.exp(b), state)
        bl = b[..., -1:, :]
        state = jnp.exp(bl)[..., 0, :, None] * state + jnp.einsum("bhsk,bhsv->bhkv", kc * jnp.exp(bl - b), vc)
        return state, o

    s0 = jnp.zeros((B, H, dk, dv), jnp.float32)
    _, o = lax.scan(step, s0, (to_chunks(q), to_chunks(k), to_chunks(v), to_chunks(logf)))
    o = o.transpose(1, 0, 3, 2, 4).reshape(B, S, H, dv)
    o = o * lax.rsqrt(jnp.mean(o * o, axis=-1, keepdims=True) + EPS) * out_gain.astype(jnp.float32)
    o = o * jax.nn.silu(hg.astype(jnp.float32).reshape(B, S, H, dv))
    return o.reshape(B, S, H * dv).astype(dt)


def setup_inputs(seed: int = 0) -> dict:
    key = jax.random.key(seed)
    ks = jax.random.split(key, 20)
    L, D, F, dh = DEPTH, D_MODEL, D_FF, NSA_HEAD_DIM

    def nrm(k, shape, scale):
        return jax.random.normal(k, shape, jnp.float32) * scale

    def gain(k, shape):
        return 1.0 + 0.01 * jax.random.normal(k, shape, jnp.float32)

    return {
        "x": nrm(ks[0], (BATCH, SEQ, D), 1.0),
        "ffn1_norm": gain(ks[1], (L, D)),
        "ffn1_w_gate": nrm(ks[2], (L, D, F), D ** -0.5),
        "ffn1_w_up": nrm(ks[3], (L, D, F), D ** -0.5),
        "ffn1_w_down": nrm(ks[4], (L, F, D), F ** -0.5),
        "mix_norm": gain(ks[5], (L, D)),
        "w_in": nrm(ks[6], (L, D, N_IN), D ** -0.5),
        "q_norm": gain(ks[7], (L, dh)),
        "k_norm": gain(ks[8], (L, 3, dh)),
        "cmp_pos": nrm(ks[9], (L, 2, CMP_BLOCK, dh), 0.02),
        "cmp_w1": nrm(ks[10], (L, 2, CMP_BLOCK, dh, CMP_HIDDEN), (CMP_BLOCK * dh) ** -0.5),
        "cmp_w2": nrm(ks[11], (L, 2, CMP_HIDDEN, dh), CMP_HIDDEN ** -0.5),
        "hgrn_lb_logits": nrm(ks[12], (L, HG_HEADS * HG_DK), 0.5),
        "hgrn_out_norm": gain(ks[13], (L, HG_DV)),
        "w_out": nrm(ks[14], (L, D_MIX, D), D_MIX ** -0.5),
        "ffn2_norm": gain(ks[15], (L, D)),
        "ffn2_w_gate": nrm(ks[16], (L, D, F), D ** -0.5),
        "ffn2_w_up": nrm(ks[17], (L, D, F), D ** -0.5),
        "ffn2_w_down": nrm(ks[18], (L, F, D), F ** -0.5),
    }


def reference(x, ffn1_norm, ffn1_w_gate, ffn1_w_up, ffn1_w_down, mix_norm, w_in, q_norm, k_norm,
              cmp_pos, cmp_w1, cmp_w2, hgrn_lb_logits, hgrn_out_norm, w_out,
              ffn2_norm, ffn2_w_gate, ffn2_w_up, ffn2_w_down):
    B, S = x.shape[0], x.shape[1]
    cos, sin = rope_tables(S, NSA_HEAD_DIM)
    lb_sm = jax.nn.softmax(hgrn_lb_logits.astype(jnp.float32), axis=0)
    lb_all = jnp.cumsum(lb_sm, axis=0) - lb_sm[0:1]
    sizes = [NSA_Q_COLS] + [NSA_KV_COLS] * 6 + [NSA_GATE_COLS, HG_K_COLS, HG_K_COLS, HG_V_COLS, HG_V_COLS]
    offsets = [int(o) for o in np.cumsum(sizes)[:-1]]

    for l in range(DEPTH):
        x = x + 0.5 * swiglu(rmsnorm(x, ffn1_norm[l]), ffn1_w_gate[l], ffn1_w_up[l], ffn1_w_down[l])
        h = rmsnorm(x, mix_norm[l])
        proj = h @ w_in[l]
        (q, kc, vc, ksl, vsl, kw, vw, gts, hq, hf, hi, hg) = jnp.split(proj, offsets, axis=-1)
        kv = lambda a: a.reshape(B, S, NSA_KV_GROUPS, NSA_HEAD_DIM)
        gates = jax.nn.sigmoid(gts.astype(jnp.float32)).reshape(B, S, NSA_HEADS, 3).astype(x.dtype)
        o_nsa = nsa_group(q.reshape(B, S, NSA_HEADS, NSA_HEAD_DIM), kv(kc), kv(vc), kv(ksl), kv(vsl),
                          kv(kw), kv(vw), gates, cos, sin, q_norm[l], k_norm[l],
                          cmp_pos[l], cmp_w1[l], cmp_w2[l])
        o_hg = hgrn2_group(hq, hf, hi, hg, lb_all[l].reshape(HG_HEADS, HG_DK), hgrn_out_norm[l])
        x = x + jnp.concatenate([o_nsa, o_hg], axis=-1) @ w_out[l]
        x = x + 0.5 * swiglu(rmsnorm(x, ffn2_norm[l]), ffn2_w_gate[l], ffn2_w_up[l], ffn2_w_down[l])
    return x
```

```cpp
#include <hip/hip_runtime.h>
#include <hip/hip_cooperative_groups.h>
#include <cstdio>
#include <cstdint>
namespace cg = cooperative_groups;

typedef unsigned short u16;
typedef unsigned long long u64;
typedef __attribute__((ext_vector_type(8))) short bf16x8;
typedef __attribute__((ext_vector_type(4))) float f32x4;
typedef float f32x2_t __attribute__((ext_vector_type(2)));
typedef __bf16 bf16x2_t __attribute__((ext_vector_type(2)));

constexpr int MT = 16384;
constexpr int SL = 4096;
constexpr int DM = 1024;
constexpr int DFF = 2816;
constexpr int NINP = 3456;
constexpr float EPSV = 1e-6f;
constexpr float SCL2 = 0.125f * 1.4426950408889634f;
constexpr float NEGB = -1e30f;
constexpr float MASKV = -3.0e38f;

constexpr size_t MiB = 1u << 20;
constexpr size_t OFF_CTL   = 0;
constexpr size_t OFF_ROWSS = 220 * MiB;
constexpr size_t OFF_COS   = 16384;
constexpr size_t OFF_SIN   = OFF_COS + 524288;
constexpr size_t OFF_LB    = OFF_SIN + 524288;
constexpr size_t OFF_CBIAS = OFF_LB + 4096;
constexpr size_t OFF_CW2T  = OFF_CBIAS + 1024;
constexpr size_t OFF_CVEM  = OFF_CW2T + 32768;
constexpr size_t OFF_CVDL  = OFF_CVEM + 524288;
constexpr size_t OFF_CVE1  = OFF_CVDL + 524288;
constexpr size_t OFF_KCC   = OFF_CVE1 + 524288;
constexpr size_t OFF_VCCT  = OFF_KCC + 262144;
constexpr size_t OFF_SEL   = OFF_VCCT + 262144;
constexpr size_t OFF_GATES = OFF_SEL + 262144;
constexpr size_t OFF_CBP   = 5 * MiB;
constexpr size_t OFF_CW1T  = 6 * MiB;
constexpr size_t OFF_WGU1  = 7 * MiB;
constexpr size_t OFF_WD1   = 18 * MiB;
constexpr size_t OFF_WIN   = 24 * MiB;
constexpr size_t OFF_WOUT  = 31 * MiB;
constexpr size_t OFF_WGU2  = 33 * MiB;
constexpr size_t OFF_WD2   = 44 * MiB;
constexpr size_t OFF_XB    = 50 * MiB;
constexpr size_t OFF_US    = OFF_XB;
constexpr size_t OFF_MIX   = 82 * MiB;
constexpr size_t OFF_R     = 114 * MiB;
constexpr size_t OFF_H     = OFF_R;
constexpr size_t OFF_Q     = OFF_R;
constexpr size_t OFF_KC    = OFF_R + 16 * MiB;
constexpr size_t OFF_VC    = OFF_R + 20 * MiB;
constexpr size_t OFF_KS    = OFF_R + 24 * MiB;
constexpr size_t OFF_VST   = OFF_R + 28 * MiB;
constexpr size_t OFF_KW    = OFF_R + 32 * MiB;
constexpr size_t OFF_VWT   = OFF_R + 36 * MiB;
constexpr size_t OFF_QTT   = OFF_R + 40 * MiB;
constexpr size_t OFF_KTT   = OFF_R + 56 * MiB;
constexpr size_t OFF_VHT   = OFF_R + 72 * MiB;
constexpr size_t OFF_HG    = OFF_R + 88 * MiB;

struct Params {
  const float *x, *ffn1_norm, *ffn1_wg, *ffn1_wu, *ffn1_wd, *mix_norm, *w_in, *q_norm, *k_norm,
      *cmp_pos, *cmp_w1, *cmp_w2, *lb_logits, *out_norm, *w_out, *ffn2_norm, *ffn2_wg, *ffn2_wu, *ffn2_wd;
  float* out;
  unsigned char* ws;
  int never;
  int pad;
};

__device__ __forceinline__ unsigned pk2(float lo, float hi) {
  f32x2_t v = {lo, hi};
  bf16x2_t b = __builtin_convertvector(v, bf16x2_t);
  return __builtin_bit_cast(unsigned, b);
}
__device__ __forceinline__ u16 f2bf(float f) { return (u16)(pk2(f, 0.f) & 0xffffu); }
__device__ __forceinline__ float bf2f(u16 v) { return __builtin_bit_cast(float, ((unsigned)v) << 16); }
__device__ __forceinline__ uint2 pk4(float a, float b, float c, float d) { return make_uint2(pk2(a, b), pk2(c, d)); }
__device__ __forceinline__ f32x4 mfma16(bf16x8 a, bf16x8 b, f32x4 c) {
  return __builtin_amdgcn_mfma_f32_16x16x32_bf16(a, b, c, 0, 0, 0);
}
__device__ __forceinline__ bf16x8 mk8(uint2 lo, uint2 hi) {
  uint4 v = make_uint4(lo.x, lo.y, hi.x, hi.y);
  return __builtin_bit_cast(bf16x8, v);
}
__device__ __forceinline__ float sigmoidf_(float x) { return __builtin_amdgcn_rcpf(1.f + __expf(-x)); }
__device__ __forceinline__ float siluf_(float x) { return x * __builtin_amdgcn_rcpf(1.f + __expf(-x)); }
__device__ __forceinline__ float ex2(float x) { return __builtin_amdgcn_exp2f(x); }

__device__ __forceinline__ int ofull() { int t = threadIdx.x; asm volatile("" : "+v"(t)); return t; }
__device__ __forceinline__ int otid() { return ofull() & 255; }
__device__ __forceinline__ int ohalf() { return __builtin_amdgcn_readfirstlane(ofull() >> 8); }
__device__ __forceinline__ int obid() { int t = blockIdx.x; asm volatile("" : "+s"(t)); return t; }
#define XB_TMO      128
#define XB_XCNT(j)  (256  + 64 * (j))
#define XB_XSUB(j)  (1280 + 64 * (j))
#define XB_XGEN(j)  (2304 + 64 * (j))
#define XB_TOP      3328
#define XB_TOPGEN   3392
#define XB_SPIN_CAP (1u << 20)
__device__ __forceinline__ unsigned xb_ld(unsigned* p) { return __hip_atomic_load(p, __ATOMIC_RELAXED, __HIP_MEMORY_SCOPE_AGENT); }
__device__ __forceinline__ unsigned xb_add(unsigned* p, unsigned v) { return __hip_atomic_fetch_add(p, v, __ATOMIC_RELAXED, __HIP_MEMORY_SCOPE_AGENT); }
__device__ __forceinline__ unsigned xb_xcc_id() { return (unsigned)__builtin_amdgcn_s_getreg((3 << 11) | 20) & 0xFu; }
#define XB_SPIN(cond, bar) do { unsigned _sp = 0; while (cond) { __builtin_amdgcn_s_sleep(1); \
    if ((++_sp & 255u) == 0u) { if (xb_ld(&(bar)[XB_TMO])) break; if (_sp > XB_SPIN_CAP) { atomicAdd(&(bar)[XB_TMO], 1u); break; } } } } while (0)
struct XcdBarrier { unsigned* bar; unsigned x; volatile unsigned* st; };
__device__ __forceinline__ void xcd_barrier_complete(unsigned* bar, unsigned x, unsigned& nloc, unsigned& nx) {
  const unsigned G = gridDim.x;
  unsigned sum, cnt, mine, sp = 0u;
  for (;;) {
    sum = 0u; cnt = 0u; mine = 0u;
#pragma unroll
    for (unsigned j = 0; j < 16; ++j) { const unsigned c = xb_ld(&bar[XB_XCNT(j)]); sum += c; cnt += (c > 0u) ? 1u : 0u; mine = (j == x) ? c : mine; }
    if (sum == G) break;
    __builtin_amdgcn_s_sleep(1);
    if ((++sp & 255u) == 0u) { if (xb_ld(&bar[XB_TMO])) break; if (sp > XB_SPIN_CAP) { atomicAdd(&bar[XB_TMO], 1u); break; } }
  }
  nloc = mine > 0u ? mine : 1u; nx = cnt > 0u ? cnt : 1u;
}
__device__ __forceinline__ void grid_bar(const XcdBarrier& b) {
  asm volatile("s_waitcnt vmcnt(0)" ::: "memory");
  __syncthreads();
  if (threadIdx.x == 0) {
    unsigned* bar = b.bar;
    __builtin_amdgcn_s_waitcnt(0);
    unsigned nloc = b.st[0], nx = b.st[1];
    if (nloc == 0u) { xcd_barrier_complete(bar, b.x, nloc, nx); b.st[0] = nloc; b.st[1] = nx; }
    const unsigned old = xb_add(&bar[XB_XSUB(b.x)], 1u);
    const unsigned gen = old / nloc;
    if (old + 1u == (gen + 1u) * nloc) {
      __builtin_amdgcn_fence(__ATOMIC_RELEASE, "agent");
      asm volatile("s_waitcnt vmcnt(0)" ::: "memory");
      const unsigned og = xb_add(&bar[XB_TOP], 1u);
      const unsigned tg = og / nx;
      if (og + 1u == (tg + 1u) * nx) xb_add(&bar[XB_TOPGEN], 1u);
      else XB_SPIN(xb_ld(&bar[XB_TOPGEN]) == tg, bar);
      __builtin_amdgcn_fence(__ATOMIC_ACQUIRE, "agent");
      xb_add(&bar[XB_XGEN(b.x)], 1u);
      asm volatile("s_waitcnt vmcnt(0)" ::: "memory");
    } else {
      XB_SPIN(xb_ld(&bar[XB_XGEN(b.x)]) == gen, bar);
      __builtin_amdgcn_fence(__ATOMIC_ACQUIRE, "agent");
      asm volatile("s_waitcnt vmcnt(0)" ::: "memory");
    }
  }
  __syncthreads();
}

__device__ __forceinline__ const float* conv_src(int type, int r, const float* s0, const float* s1) {
  if (type == 0) return s0 + r;
  if (type == 1) { int grp = r >> 5, w = r & 31; int h = grp * 16 + (w & 15); return (w < 16 ? s0 : s1) + h; }
  if (r < 1280) return s0 + r;
  if (r < 2304) { int rr = r - 1280; int grp = rr >> 5, w = rr & 31; int ch = grp * 16 + (w & 15); return s0 + 1304 + (w < 16 ? 0 : 512) + ch; }
  if (r < 2816) return s0 + 1304 + 1024 + (r - 2304);
  if (r < 3328) return s0 + 1304 + 1536 + (r - 2816);
  if (r < 3352) return s0 + 1280 + (r - 3328);
  return nullptr;
}
__device__ void conv_tile(int type, const float* s0, const float* s1, int ldsrc, const float* gain, int K,
                          u16* dst, int r0, int k0, float* lds, bool valid) {
  const int tid = otid(), tx = tid & 63, ty = tid >> 6;
  const float* sp = valid ? conv_src(type, r0 + tx, s0, s1) : nullptr;
  float vals[32];
#pragma unroll
  for (int i = 0; i < 32; i++) {
    const int k = k0 + ty * 32 + i;
    vals[i] = sp ? sp[(size_t)k * ldsrc] : 0.f;
  }
#pragma unroll
  for (int i = 0; i < 32; i++) {
    const int k = k0 + ty * 32 + i;
    float v = vals[i];
    if (gain) v *= gain[k];
    lds[(ty * 32 + i) * 65 + tx] = v;
  }
  __syncthreads();
  const int rr = tid >> 2, ks = (tid & 3) * 32;
  unsigned w[16];
#pragma unroll
  for (int i = 0; i < 16; i++) w[i] = pk2(lds[(ks + 2 * i) * 65 + rr], lds[(ks + 2 * i + 1) * 65 + rr]);
  if (valid) {
    uint4* dp = (uint4*)(dst + (size_t)(r0 + rr) * K + k0 + ks);
    dp[0] = make_uint4(w[0], w[1], w[2], w[3]);
    dp[1] = make_uint4(w[4], w[5], w[6], w[7]);
    dp[2] = make_uint4(w[8], w[9], w[10], w[11]);
    dp[3] = make_uint4(w[12], w[13], w[14], w[15]);
  }
  __syncthreads();
}
__device__ void conv_matrix(int type, const float* s0, const float* s1, int ldsrc, const float* gain, int K, int NR,
                            u16* dst, float* lds, int& cursor) {
  const int tk = K / 128, tiles = (NR / 64) * tk, npairs = (tiles + 1) >> 1;
  const int G = (int)gridDim.x, half = ohalf();
  int first = ((int)blockIdx.x - (cursor % G) + G) % G;
  for (int pi = first; pi < npairs; pi += G) {
    const int t = 2 * pi + half;
    const bool valid = t < tiles;
    const int tt = valid ? t : 0;
    conv_tile(type, s0, s1, ldsrc, gain, K, dst, (tt / tk) * 64, (tt % tk) * 128, lds + half * 8448, valid);
  }
  cursor += npairs;
}

__device__ void phase_convert(const Params& p, int l, float* lds) {
  unsigned char* ws = p.ws;
  int cur = 0;
  const size_t oFF = (size_t)l * DM * DFF;
#pragma unroll 1
  for (int mi = 0; mi < 10; mi++) {
    int type = 0, ldsrc = DM, K = DM, NR = DM;
    const float *s0 = nullptr, *s1 = nullptr, *gain = nullptr;
    u16* dst = nullptr;
    switch (mi) {
      case 0: type = 1; s0 = p.ffn1_wg + oFF; s1 = p.ffn1_wu + oFF; ldsrc = DFF; gain = p.ffn1_norm + l * DM; K = DM; NR = 2 * DFF; dst = (u16*)(ws + OFF_WGU1); break;
      case 1: type = 0; s0 = p.ffn1_wd + oFF; ldsrc = DM; K = DFF; NR = DM; dst = (u16*)(ws + OFF_WD1); break;
      case 2: type = 2; s0 = p.w_in + (size_t)l * DM * 3352; ldsrc = 3352; gain = p.mix_norm + l * DM; K = DM; NR = NINP; dst = (u16*)(ws + OFF_WIN); break;
      case 3: type = 0; s0 = p.w_out + (size_t)l * DM * DM; ldsrc = DM; K = DM; NR = DM; dst = (u16*)(ws + OFF_WOUT); break;
      case 4: type = 1; s0 = p.ffn2_wg + oFF; s1 = p.ffn2_wu + oFF; ldsrc = DFF; gain = p.ffn2_norm + l * DM; K = DM; NR = 2 * DFF; dst = (u16*)(ws + OFF_WGU2); break;
      case 5: type = 0; s0 = p.ffn2_wd + oFF; ldsrc = DM; K = DFF; NR = DM; dst = (u16*)(ws + OFF_WD2); break;
      case 6: case 7: { const int kv = mi - 6; type = 0; s0 = p.cmp_w1 + (size_t)(l * 2 + kv) * 2048 * 128; ldsrc = 128; K = 2048; NR = 128; dst = (u16*)(ws + OFF_CW1T) + (size_t)kv * 128 * 2048; } break;
      default: { const int kv = mi - 8; type = 0; s0 = p.cmp_w2 + (size_t)(l * 2 + kv) * 128 * 64; ldsrc = 64; K = 128; NR = 64; dst = (u16*)(ws + OFF_CW2T) + (size_t)kv * 64 * 128; } break;
    }
    conv_matrix(type, s0, s1, ldsrc, gain, K, NR, dst, lds, cur);
  }
  if (blockIdx.x < 16 && ohalf() == 0) {
    const int kv = otid() >> 7, e = otid() & 127;
    const float* pos = p.cmp_pos + (size_t)(l * 2 + kv) * 2048 + blockIdx.x * 128;
    const float* w1 = p.cmp_w1 + ((size_t)(l * 2 + kv) * 2048 + blockIdx.x * 128) * 128;
    float sacc = 0.f;
#pragma unroll 64
    for (int i = 0; i < 128; i++) sacc += pos[i] * w1[(size_t)i * 128 + e];
    ((float*)(ws + OFF_CBP))[blockIdx.x * 256 + kv * 128 + e] = sacc;
  }
}

__device__ void phase_init(const Params& p) {
  unsigned char* ws = p.ws;
  const int tid = ofull(), lane = tid & 63, wid = tid >> 6;
  const int gw = blockIdx.x * 8 + wid, nw = gridDim.x * 8;
  float* rowss = (float*)(ws + OFF_ROWSS);
  u16* xb = (u16*)(ws + OFF_XB);
  for (int m = gw; m < MT; m += 2 * nw) {
    const int m2 = m + nw;
    const float4* xr = (const float4*)(p.x + (size_t)m * DM);
    const float4* xr2 = (const float4*)(p.x + (size_t)m2 * DM);
    float4 va[4], vb[4];
#pragma unroll
    for (int i = 0; i < 4; i++) { va[i] = xr[lane + 64 * i]; vb[i] = xr2[lane + 64 * i]; }
    float ss = 0.f, ss2 = 0.f;
#pragma unroll
    for (int i = 0; i < 4; i++) {
      const float4 v = va[i], w_ = vb[i];
      *(uint2*)(xb + (size_t)m * DM + (lane + 64 * i) * 4) = pk4(v.x, v.y, v.z, v.w);
      *(uint2*)(xb + (size_t)m2 * DM + (lane + 64 * i) * 4) = pk4(w_.x, w_.y, w_.z, w_.w);
      ss += v.x * v.x + v.y * v.y + v.z * v.z + v.w * v.w;
      ss2 += w_.x * w_.x + w_.y * w_.y + w_.z * w_.z + w_.w * w_.w;
    }
#pragma unroll
    for (int o = 32; o > 0; o >>= 1) { ss += __shfl_xor(ss, o); ss2 += __shfl_xor(ss2, o); }
    if (lane < 16) {
      rowss[(size_t)m * 16 + lane] = (lane == 0) ? ss : 0.f;
      rowss[(size_t)m2 * 16 + lane] = (lane == 0) ? ss2 : 0.f;
    }
  }
  const int gt = blockIdx.x * 512 + tid, nt = gridDim.x * 512;
  float* ct = (float*)(ws + OFF_COS);
  float* st = (float*)(ws + OFF_SIN);
  for (int i = gt; i < SL * 32; i += nt) {
    int t = i >> 5, d = i & 31;
    float inv = 1.0f / powf(10000.0f, (float)(2 * d) / 64.0f);
    float ang = (float)t * inv;
    ct[i] = cosf(ang);
    st[i] = sinf(ang);
  }
  float* lb = (float*)(ws + OFF_LB);
  for (int i = gt; i < 512; i += nt) {
    float z0 = p.lb_logits[i], z1 = p.lb_logits[512 + i];
    float mx = fmaxf(z0, z1);
    float e0 = expf(z0 - mx), e1 = expf(z1 - mx);
    lb[i] = 0.f;
    lb[512 + i] = e1 / (e0 + e1);
  }
}

template <int OFF> __device__ __forceinline__ bf16x8 ldsr128(unsigned addr) {
  bf16x8 v;
  asm volatile("ds_read_b128 %0, %1 offset:%2" : "=v"(v) : "v"(addr), "n"(OFF));
  return v;
}
__device__ __forceinline__ void lds_wait8(bf16x8& a0, bf16x8& a1, bf16x8& a2, bf16x8& a3, bf16x8& b0, bf16x8& b1, bf16x8& b2, bf16x8& b3) {
  asm volatile("s_waitcnt lgkmcnt(0)" : "+v"(a0), "+v"(a1), "+v"(a2), "+v"(a3), "+v"(b0), "+v"(b1), "+v"(b2), "+v"(b3));
}
template <int OFF> __device__ __forceinline__ uint2 ldsr64(unsigned addr) {
  uint2 v;
  asm volatile("ds_read_b64 %0, %1 offset:%2" : "=v"(v) : "v"(addr), "n"(OFF));
  return v;
}
template <int OFF> __device__ __forceinline__ uint2 ldstr64(unsigned addr) {
  uint2 v;
  asm volatile("ds_read_b64_tr_b16 %0, %1 offset:%2" : "=v"(v) : "v"(addr), "n"(OFF));
  return v;
}
constexpr int SM_GEMM = 131072;

template <bool BIG, bool M4>
__device__ __forceinline__ void gemm_main8(const u16* __restrict__ A, int lda, const u16* __restrict__ Bt, int ldb, int K,
                                           u16* sm, f32x4 (&acc)[2][4][4]) {
  constexpr int STG = BIG ? 65536 : 49152;
  const int tid = ofull(), lane = tid & 63, wid = tid >> 6;
  const int wr = BIG ? (wid >> 2) : (wid >> 1), wc = BIG ? (wid & 3) : (wid & 1);
  const int lr = lane & 15, quad = lane >> 4;
  const int ldrow = tid >> 3, lc = (tid & 7) ^ (ldrow & 7);
  const u16* ap = A + (size_t)ldrow * lda + lc * 8;
  const u16* bp = Bt + (size_t)ldrow * ldb + lc * 8;
  unsigned char* smb = (unsigned char*)sm;
#define GEMM_ISSUE(stage, k0)                                                                                         \
  do {                                                                                                                \
    _Pragma("unroll") for (int i_ = 0; i_ < 4; i_++)                                                                  \
      __builtin_amdgcn_global_load_lds((const unsigned*)(ap + (size_t)i_ * 64 * lda + (k0)),                          \
                                       (unsigned*)(smb + (stage) * STG + (tid + 512 * i_) * 16), 16, 0, 0);           \
    _Pragma("unroll") for (int i_ = 0; i_ < (BIG ? 4 : 2); i_++)                                                      \
      __builtin_amdgcn_global_load_lds((const unsigned*)(bp + (size_t)i_ * 64 * ldb + (k0)),                          \
                                       (unsigned*)(smb + (stage) * STG + 32768 + (tid + 512 * i_) * 16), 16, 0, 0);   \
  } while (0)
  const unsigned smbase = (unsigned)(size_t)smb;
  const int nk = K >> 6;
  GEMM_ISSUE(0, 0);
#pragma unroll
  for (int h = 0; h < 2; h++)
#pragma unroll
    for (int mf = 0; mf < 4; mf++)
#pragma unroll
      for (int nf = 0; nf < 4; nf++) acc[h][mf][nf] = f32x4{0.f, 0.f, 0.f, 0.f};
  const int sw0 = (quad ^ (lr & 7)) * 16, sw1 = sw0 ^ 64;
  const int arow = (wr * (BIG ? 128 : 64) + lr) * 128, brow = 32768 + (wc * 64 + lr) * 128;
#pragma unroll 1
  for (int kt = 0; kt < nk; kt++) {
    asm volatile("s_waitcnt vmcnt(0)" ::: "memory");
    __builtin_amdgcn_s_barrier();
    __builtin_amdgcn_sched_barrier(0);
    const unsigned sb_ = smbase + (kt & 1) * STG;
    if (BIG) {
      const unsigned ca0 = sb_ + arow + sw0, cb0 = sb_ + brow + sw0, ca1 = sb_ + arow + sw1, cb1 = sb_ + brow + sw1;
      bf16x8 b0[4], b1[4], af[4], ag[4];
      b0[0] = ldsr128<0>(cb0); b0[1] = ldsr128<2048>(cb0); b0[2] = ldsr128<4096>(cb0); b0[3] = ldsr128<6144>(cb0);
      af[0] = ldsr128<0>(ca0); af[1] = ldsr128<2048>(ca0); af[2] = ldsr128<4096>(ca0); af[3] = ldsr128<6144>(ca0);
      if (kt + 1 < nk) GEMM_ISSUE((kt + 1) & 1, (kt + 1) * 64);
      asm volatile("s_waitcnt lgkmcnt(0)" : "+v"(af[0]), "+v"(af[1]), "+v"(af[2]), "+v"(af[3]), "+v"(b0[0]), "+v"(b0[1]), "+v"(b0[2]), "+v"(b0[3]));
      ag[0] = ldsr128<8192>(ca0); ag[1] = ldsr128<10240>(ca0); ag[2] = ldsr128<12288>(ca0); ag[3] = ldsr128<14336>(ca0);
      __builtin_amdgcn_s_setprio(1);
#pragma unroll
      for (int mf = 0; mf < 4; mf++)
#pragma unroll
        for (int nf = 0; nf < 4; nf++) acc[0][mf][nf] = M4 ? mfma16(af[mf], b0[nf], acc[0][mf][nf]) : mfma16(b0[nf], af[mf], acc[0][mf][nf]);
      __builtin_amdgcn_s_setprio(0);
      asm volatile("s_waitcnt lgkmcnt(0)" : "+v"(ag[0]), "+v"(ag[1]), "+v"(ag[2]), "+v"(ag[3]));
      b1[0] = ldsr128<0>(cb1); b1[1] = ldsr128<2048>(cb1); b1[2] = ldsr128<4096>(cb1); b1[3] = ldsr128<6144>(cb1);
      af[0] = ldsr128<0>(ca1); af[1] = ldsr128<2048>(ca1); af[2] = ldsr128<4096>(ca1); af[3] = ldsr128<6144>(ca1);
      __builtin_amdgcn_s_setprio(1);
#pragma unroll
      for (int mf = 0; mf < 4; mf++)
#pragma unroll
        for (int nf = 0; nf < 4; nf++) acc[1][mf][nf] = M4 ? mfma16(ag[mf], b0[nf], acc[1][mf][nf]) : mfma16(b0[nf], ag[mf], acc[1][mf][nf]);
      __builtin_amdgcn_s_setprio(0);
      asm volatile("s_waitcnt lgkmcnt(0)" : "+v"(af[0]), "+v"(af[1]), "+v"(af[2]), "+v"(af[3]), "+v"(b1[0]), "+v"(b1[1]), "+v"(b1[2]), "+v"(b1[3]));
      ag[0] = ldsr128<8192>(ca1); ag[1] = ldsr128<10240>(ca1); ag[2] = ldsr128<12288>(ca1); ag[3] = ldsr128<14336>(ca1);
      __builtin_amdgcn_s_setprio(1);
#pragma unroll
      for (int mf = 0; mf < 4; mf++)
#pragma unroll
        for (int nf = 0; nf < 4; nf++) acc[0][mf][nf] = M4 ? mfma16(af[mf], b1[nf], acc[0][mf][nf]) : mfma16(b1[nf], af[mf], acc[0][mf][nf]);
      __builtin_amdgcn_s_setprio(0);
      asm volatile("s_waitcnt lgkmcnt(0)" : "+v"(ag[0]), "+v"(ag[1]), "+v"(ag[2]), "+v"(ag[3]));
      __builtin_amdgcn_s_setprio(1);
#pragma unroll
      for (int mf = 0; mf < 4; mf++)
#pragma unroll
        for (int nf = 0; nf < 4; nf++) acc[1][mf][nf] = M4 ? mfma16(ag[mf], b1[nf], acc[1][mf][nf]) : mfma16(b1[nf], ag[mf], acc[1][mf][nf]);
      __builtin_amdgcn_s_setprio(0);
    } else {
      const unsigned ca0 = sb_ + arow + sw0, cb0 = sb_ + brow + sw0, ca1 = sb_ + arow + sw1, cb1 = sb_ + brow + sw1;
      bf16x8 b0[4], a0[4], b1[4], a1[4];
      b0[0] = ldsr128<0>(cb0); b0[1] = ldsr128<2048>(cb0); b0[2] = ldsr128<4096>(cb0); b0[3] = ldsr128<6144>(cb0);
      a0[0] = ldsr128<0>(ca0); a0[1] = ldsr128<2048>(ca0); a0[2] = ldsr128<4096>(ca0); a0[3] = ldsr128<6144>(ca0);
      if (kt + 1 < nk) GEMM_ISSUE((kt + 1) & 1, (kt + 1) * 64);
      asm volatile("s_waitcnt lgkmcnt(0)" : "+v"(a0[0]), "+v"(a0[1]), "+v"(a0[2]), "+v"(a0[3]), "+v"(b0[0]), "+v"(b0[1]), "+v"(b0[2]), "+v"(b0[3]));
      b1[0] = ldsr128<0>(cb1); b1[1] = ldsr128<2048>(cb1); b1[2] = ldsr128<4096>(cb1); b1[3] = ldsr128<6144>(cb1);
      a1[0] = ldsr128<0>(ca1); a1[1] = ldsr128<2048>(ca1); a1[2] = ldsr128<4096>(ca1); a1[3] = ldsr128<6144>(ca1);
#pragma unroll
      for (int mf = 0; mf < 4; mf++)
#pragma unroll
        for (int nf = 0; nf < 4; nf++) {
          if (M4) acc[0][mf][nf] = mfma16(a0[mf], b0[nf], acc[0][mf][nf]);
          else    acc[0][mf][nf] = mfma16(b0[nf], a0[mf], acc[0][mf][nf]);
        }
      asm volatile("s_waitcnt lgkmcnt(0)" : "+v"(a1[0]), "+v"(a1[1]), "+v"(a1[2]), "+v"(a1[3]), "+v"(b1[0]), "+v"(b1[1]), "+v"(b1[2]), "+v"(b1[3]));
#pragma unroll
      for (int mf = 0; mf < 4; mf++)
#pragma unroll
        for (int nf = 0; nf < 4; nf++) {
          if (M4) acc[0][mf][nf] = mfma16(a1[mf], b1[nf], acc[0][mf][nf]);
          else    acc[0][mf][nf] = mfma16(b1[nf], a1[mf], acc[0][mf][nf]);
        }
    }
  }
  __syncthreads();
#undef GEMM_ISSUE
}

__device__ __forceinline__ bool tile_of(int u_iter, int NT, int& mt, int& nt) {
  const int nx = 8;
  const int per = gridDim.x / nx;
  const int xcd = blockIdx.x % nx, local = blockIdx.x / nx;
  if ((int)blockIdx.x >= per * nx) return false;
  const int u = local + u_iter * per;
  if (u >= 8 * NT) return false;
  mt = xcd * 8 + (u & 7);
  nt = u >> 3;
  return true;
}

__device__ __forceinline__ void epi_swiglu(f32x4 (&acc)[4][4], int mb, int nb, const float* rsl, u16* H) {
  const int lane = otid() & 63, lr = lane & 15, quad = lane >> 4;
#pragma unroll
  for (int mf = 0; mf < 4; mf++) {
    const int m = mb + mf * 16 + lr;
    const float rs = rsl[mf * 16 + lr];
#pragma unroll
    for (int pp = 0; pp < 2; pp++) {
      float h[4];
#pragma unroll
      for (int j = 0; j < 4; j++) {
        float g = acc[mf][2 * pp][j] * rs, u = acc[mf][2 * pp + 1][j] * rs;
        h[j] = siluf_(g) * u;
      }
      const int hid = (nb >> 1) + pp * 16 + quad * 4;
      *(uint2*)(H + (size_t)m * DFF + hid) = pk4(h[0], h[1], h[2], h[3]);
    }
  }
}
__device__ __forceinline__ void epi_resid(f32x4 (&acc)[4][4], int mb, int nb, float scale, float* x, u16* xb, float* rowss_next) {
  const int lane = otid() & 63, lr = lane & 15, quad = lane >> 4;
#pragma unroll
  for (int mf = 0; mf < 4; mf++) {
    const int m = mb + mf * 16 + lr;
    float ss = 0.f;
#pragma unroll
    for (int nf = 0; nf < 4; nf++) {
      const int n = nb + nf * 16 + quad * 4;
      float4* xp = (float4*)(x + (size_t)m * DM + n);
      float4 xv = *xp;
      xv.x += scale * acc[mf][nf][0]; xv.y += scale * acc[mf][nf][1];
      xv.z += scale * acc[mf][nf][2]; xv.w += scale * acc[mf][nf][3];
      *xp = xv;
      *(uint2*)(xb + (size_t)m * DM + n) = pk4(xv.x, xv.y, xv.z, xv.w);
      ss += xv.x * xv.x + xv.y * xv.y + xv.z * xv.z + xv.w * xv.w;
    }
    ss += __shfl_xor(ss, 16);
    ss += __shfl_xor(ss, 32);
    if (quad == 0) rowss_next[(size_t)m * 16 + (nb >> 6)] = ss;
  }
}

__device__ __forceinline__ void epi_swiglu_lds(f32x4 (&acc)[4][4], int mb, int nb, const float* rsl, u16* H, float* T) {
  const int lane = otid() & 63, lr = lane & 15, quad = lane >> 4;
#pragma unroll
  for (int mf = 0; mf < 4; mf++)
#pragma unroll
    for (int nf = 0; nf < 4; nf++)
      *(f32x4*)(T + (mf * 16 + lr) * 64 + (((nf * 4 + quad) ^ lr) * 4)) = acc[mf][nf];
  const int l8 = lane & 7, gch = (l8 < 4) ? l8 : l8 + 4, uch = gch + 4;
#pragma unroll
  for (int i = 0; i < 8; i++) {
    const int r = (lane >> 3) + 8 * i;
    const f32x4 g4 = *(const f32x4*)(T + r * 64 + ((gch ^ (r & 15)) * 4));
    const f32x4 u4 = *(const f32x4*)(T + r * 64 + ((uch ^ (r & 15)) * 4));
    const float rs = rsl[r];
    float h[4];
#pragma unroll
    for (int j = 0; j < 4; j++) h[j] = siluf_(g4[j] * rs) * (u4[j] * rs);
    *(uint2*)(H + (size_t)(mb + r) * DFF + (nb >> 1) + l8 * 4) = pk4(h[0], h[1], h[2], h[3]);
  }
}

__device__ __forceinline__ void epi_resid_lds(f32x4 (&acc)[4][4], int mb, int nb, float scale, float* xout, u16* xb, float* rowss_next, float* T) {
  const int lane = otid() & 63, lr = lane & 15, quad = lane >> 4;
#pragma unroll
  for (int mf = 0; mf < 4; mf++)
#pragma unroll
    for (int nf = 0; nf < 4; nf++)
      *(f32x4*)(T + (mf * 16 + lr) * 64 + (((nf * 4 + quad) ^ lr) * 4)) = acc[mf][nf];
  uint2 xin[16];
#pragma unroll
  for (int i = 0; i < 16; i++) xin[i] = *(const uint2*)(xb + (size_t)(mb + quad + 4 * i) * DM + nb + lr * 4);
#pragma unroll
  for (int i = 0; i < 16; i++) {
    const int r = quad + 4 * i, c4 = lr;
    const f32x4 a = *(const f32x4*)(T + r * 64 + ((c4 ^ (r & 15)) * 4));
    const int m = mb + r, n = nb + c4 * 4;
    float4 xv;
    xv.x = bf2f((u16)(xin[i].x & 0xffff)) + scale * a[0];
    xv.y = bf2f((u16)(xin[i].x >> 16)) + scale * a[1];
    xv.z = bf2f((u16)(xin[i].y & 0xffff)) + scale * a[2];
    xv.w = bf2f((u16)(xin[i].y >> 16)) + scale * a[3];
    if (xout) {
      *(float4*)(xout + (size_t)m * DM + n) = xv;
    } else {
      *(uint2*)(xb + (size_t)m * DM + n) = pk4(xv.x, xv.y, xv.z, xv.w);
      float ss = xv.x * xv.x + xv.y * xv.y + xv.z * xv.z + xv.w * xv.w;
      ss += __shfl_xor(ss, 1);
      ss += __shfl_xor(ss, 2);
      ss += __shfl_xor(ss, 4);
      ss += __shfl_xor(ss, 8);
      if (c4 == 0) rowss_next[(size_t)m * 16 + (nb >> 6)] = ss;
    }
  }
}

__device__ __forceinline__ void epi_inproj_n4(const Params& p, int l, f32x4 (&acc)[4][4], int mb, int nt, int wc, const float* rsl) {
  unsigned char* ws = p.ws;
  const int lane = otid() & 63, lr = lane & 15, quad = lane >> 4;
  const float* ct = (const float*)(ws + OFF_COS);
  const float* st = (const float*)(ws + OFF_SIN);
#pragma unroll
  for (int mf = 0; mf < 4; mf++) {
    const int m = mb + mf * 16 + lr;
    const int b = m >> 12, t = m & 4095;
    const float rs = rsl[mf * 16 + lr];
    float v[4][4];
#pragma unroll
    for (int nf = 0; nf < 4; nf++)
#pragma unroll
      for (int j = 0; j < 4; j++) v[nf][j] = acc[mf][nf][j] * rs;
    if (nt == 26) {
      if (wc == 0) {
        float* gp = (float*)(ws + OFF_GATES) + (size_t)m * 24;
#pragma unroll
        for (int nf = 0; nf < 2; nf++)
#pragma unroll
          for (int j = 0; j < 4; j++) { int c = nf * 16 + quad * 4 + j; if (c < 24) gp[c] = sigmoidf_(v[nf][j]); }
      }
    } else if (nt >= 22) {
      u16* dp = (u16*)(ws + OFF_HG) + (size_t)m * 512 + (nt - 22) * 128 + wc * 64 + quad * 4;
#pragma unroll
      for (int nf = 0; nf < 4; nf++) *(uint2*)(dp + nf * 16) = pk4(v[nf][0], v[nf][1], v[nf][2], v[nf][3]);
    } else if (nt == 5) {
      u16* dp = (u16*)(ws + OFF_VC) + ((size_t)((b * 2 + wc) * SL + t)) * 64 + quad * 4;
#pragma unroll
      for (int nf = 0; nf < 4; nf++) *(uint2*)(dp + nf * 16) = pk4(v[nf][0], v[nf][1], v[nf][2], v[nf][3]);
    } else {
      const float* gain;
      u16* dp;
      if (nt < 4) { gain = p.q_norm + l * 64; dp = (u16*)(ws + OFF_Q) + (size_t)m * 512 + (nt * 2 + wc) * 64; }
      else {
        const int ki = (nt - 4) >> 1;
        gain = p.k_norm + (l * 3 + ki) * 64;
        const size_t off = (nt == 4) ? OFF_KC : (nt == 6 ? OFF_KS : OFF_KW);
        dp = (u16*)(ws + off) + ((size_t)((b * 2 + wc) * SL + t)) * 64;
      }
      float ss = 0.f;
#pragma unroll
      for (int nf = 0; nf < 4; nf++)
#pragma unroll
        for (int j = 0; j < 4; j++) ss += v[nf][j] * v[nf][j];
      ss += __shfl_xor(ss, 16);
      ss += __shfl_xor(ss, 32);
      float r = rsqrtf(ss * (1.f / 64.f) + EPSV);
      if (nt < 4) r *= SCL2;
#pragma unroll
      for (int nf = 0; nf < 4; nf++) {
        const float4 g4 = *(const float4*)(gain + nf * 16 + quad * 4);
        v[nf][0] *= r * g4.x; v[nf][1] *= r * g4.y; v[nf][2] *= r * g4.z; v[nf][3] *= r * g4.w;
      }
#pragma unroll
      for (int nf = 0; nf < 2; nf++) {
        const float4 c4 = *(const float4*)(ct + t * 32 + nf * 16 + quad * 4);
        const float4 s4 = *(const float4*)(st + t * 32 + nf * 16 + quad * 4);
        const float cc[4] = {c4.x, c4.y, c4.z, c4.w}, sn[4] = {s4.x, s4.y, s4.z, s4.w};
        float lo[4], hi[4];
#pragma unroll
        for (int j = 0; j < 4; j++) {
          lo[j] = v[nf][j] * cc[j] - v[nf + 2][j] * sn[j];
          hi[j] = v[nf + 2][j] * cc[j] + v[nf][j] * sn[j];
        }
        *(uint2*)(dp + nf * 16 + quad * 4) = pk4(lo[0], lo[1], lo[2], lo[3]);
        *(uint2*)(dp + (nf + 2) * 16 + quad * 4) = pk4(hi[0], hi[1], hi[2], hi[3]);
      }
    }
    __builtin_amdgcn_sched_barrier(0);
  }
}

__device__ __forceinline__ void epi_inproj_m4(const Params& p, int l, f32x4 (&acc)[4][4], int mb, int nt, int wc, const float* rsl) {
  unsigned char* ws = p.ws;
  const int lane = otid() & 63, lr = lane & 15, quad = lane >> 4;
  float rs[4][4];
#pragma unroll
  for (int mf = 0; mf < 4; mf++) {
    const float4 r4 = *(const float4*)(rsl + mf * 16 + quad * 4);
    rs[mf][0] = r4.x; rs[mf][1] = r4.y; rs[mf][2] = r4.z; rs[mf][3] = r4.w;
  }
  if (nt == 7 || nt == 9) {
    u16* base = (u16*)(ws + (nt == 7 ? OFF_VST : OFF_VWT));
#pragma unroll
    for (int mf = 0; mf < 4; mf++) {
      const int m0 = mb + mf * 16 + quad * 4;
      const int b = m0 >> 12, t0 = m0 & 4095;
#pragma unroll
      for (int nf = 0; nf < 4; nf++) {
        const int d = nf * 16 + lr;
        *(uint2*)(base + ((size_t)((b * 2 + wc) * 64 + d)) * SL + t0) =
            pk4(acc[mf][nf][0] * rs[mf][0], acc[mf][nf][1] * rs[mf][1], acc[mf][nf][2] * rs[mf][2], acc[mf][nf][3] * rs[mf][3]);
      }
    }
  } else if (nt >= 18) {
    u16* base = (u16*)(ws + OFF_VHT);
#pragma unroll
    for (int mf = 0; mf < 4; mf++) {
      const int m0 = mb + mf * 16 + quad * 4;
#pragma unroll
      for (int nf = 0; nf < 4; nf++) {
        const int ch = (nt - 18) * 128 + wc * 64 + nf * 16 + lr;
        *(uint2*)(base + (size_t)ch * MT + m0) =
            pk4(acc[mf][nf][0] * rs[mf][0], acc[mf][nf][1] * rs[mf][1], acc[mf][nf][2] * rs[mf][2], acc[mf][nf][3] * rs[mf][3]);
      }
    }
  } else {
    const float* lbp = (const float*)(ws + OFF_LB) + l * 512;
    u16* qtT = (u16*)(ws + OFF_QTT);
    u16* ktT = (u16*)(ws + OFF_KTT);
    const int chunk = mb >> 6;
#pragma unroll
    for (int pp = 0; pp < 2; pp++) {
      const int ch = (nt - 10) * 64 + wc * 32 + pp * 16 + lr;
      const float lbv = lbp[ch];
      float bv[4][4], kk[4][4];
      float run = 0.f;
#pragma unroll
      for (int mf = 0; mf < 4; mf++) {
        float lf[4];
#pragma unroll
        for (int j = 0; j < 4; j++) {
          const float xf = acc[mf][2 * pp + 1][j] * rs[mf][j];
          const float sg = __builtin_amdgcn_rcpf(1.f + __expf(-xf));
          const float nsg = __builtin_amdgcn_rcpf(1.f + __expf(xf));
          const float f = lbv + (1.f - lbv) * sg;
          lf[j] = __logf(fmaxf(f, 1e-30f));
          kk[mf][j] = (1.f - lbv) * nsg;
        }
        const float c0 = lf[0], c1 = c0 + lf[1], c2 = c1 + lf[2], c3 = c2 + lf[3];
        const float t0 = __shfl(c3, lr), t1 = __shfl(c3, lr + 16), t2 = __shfl(c3, lr + 32), t3 = __shfl(c3, lr + 48);
        const float pre = (quad > 0 ? t0 : 0.f) + (quad > 1 ? t1 : 0.f) + (quad > 2 ? t2 : 0.f);
        const float base = run + pre;
        bv[mf][0] = base + c0; bv[mf][1] = base + c1; bv[mf][2] = base + c2; bv[mf][3] = base + c3;
        run += t0 + t1 + t2 + t3;
      }
      const float bm = __shfl(bv[1][3], lr + 48);
      const float bl = __shfl(bv[3][3], lr + 48);
#pragma unroll
      for (int mf = 0; mf < 4; mf++) {
        const int m0 = mb + mf * 16 + quad * 4;
        float qv[4], kv[4];
#pragma unroll
        for (int j = 0; j < 4; j++) {
          const float xq = acc[mf][2 * pp][j] * rs[mf][j];
          qv[j] = siluf_(xq) * __expf(bv[mf][j] - bm);
          kv[j] = kk[mf][j] * __expf(bm - bv[mf][j]);
        }
        *(uint2*)(qtT + (size_t)ch * MT + m0) = pk4(qv[0], qv[1], qv[2], qv[3]);
        *(uint2*)(ktT + (size_t)ch * MT + m0) = pk4(kv[0], kv[1], kv[2], kv[3]);
      }
      if (quad == 0) {
        ((float*)(ws + OFF_CVEM))[chunk * 512 + ch] = __expf(bm);
        ((float*)(ws + OFF_CVDL))[chunk * 512 + ch] = __expf(bl);
        ((float*)(ws + OFF_CVE1))[chunk * 512 + ch] = __expf(bl - bm);
      }
    }
  }
}

enum { G_UP = 0, G_DOWN = 1, G_INPROJ = 2 };

__device__ __forceinline__ void phase_gemm(const Params& p, int l, int kind, const u16* A, int lda, const u16* Bt, int ldb, int K, int NT,
                           const float* rowss_in, float* rowss_out, float scale, u16* Hout, u16* sm, bool fin = false) {
  const int ftid = ofull(), wid = ftid >> 6;
  float* rsl_all = (float*)((unsigned char*)sm + SM_GEMM);
  f32x4 acc[2][4][4];
  const int per_ = gridDim.x / 8, full_ = (8 * NT) / per_, rem_ = 8 * NT - full_ * per_;
  const bool split_tail = (kind == G_UP || kind == G_INPROJ) && (rem_ * 2 == per_);
  float* Tw = (float*)((unsigned char*)sm + wid * 16384);
  for (int it = 0;; it++) {
    int mt, nt;
    if (split_tail && it == full_) {
      const int local = blockIdx.x / 8, xcd = blockIdx.x % 8;
      const int u = full_ * per_ + (local >> 1), nh = local & 1;
      mt = xcd * 8 + (u & 7); nt = u >> 3;
      const int m0 = mt * 256;
      __syncthreads();
      if (ftid < 256) {
        const float4* rp = (const float4*)(rowss_in + (size_t)(m0 + ftid) * 16);
        const float4 a0 = rp[0], a1 = rp[1], a2 = rp[2], a3 = rp[3];
        float sm_ = ((a0.x + a0.y) + (a0.z + a0.w)) + ((a1.x + a1.y) + (a1.z + a1.w)) + ((a2.x + a2.y) + (a2.z + a2.w)) + ((a3.x + a3.y) + (a3.z + a3.w));
        rsl_all[ftid] = rsqrtf(sm_ * (1.f / 1024.f) + EPSV);
      }
      const int wr = wid >> 1, wc = wid & 1;
      const int n0 = nt * 256 + nh * 128;
      if (kind == G_UP) {
        gemm_main8<false, false>(A + (size_t)m0 * lda, lda, Bt + (size_t)n0 * ldb, ldb, K, sm, acc);
        epi_swiglu(acc[0], m0 + wr * 64, n0 + wc * 64, rsl_all + wr * 64, Hout);
      } else {
        const int nt128 = n0 >> 7;
        const bool m4 = (nt128 == 7 || nt128 == 9 || (nt128 >= 10 && nt128 < 22));
        if (m4) gemm_main8<false, true>(A + (size_t)m0 * lda, lda, Bt + (size_t)n0 * ldb, ldb, K, sm, acc);
        else    gemm_main8<false, false>(A + (size_t)m0 * lda, lda, Bt + (size_t)n0 * ldb, ldb, K, sm, acc);
        if (nt128 < 27) {
          if (m4) epi_inproj_m4(p, l, acc[0], m0 + wr * 64, nt128, wc, rsl_all + wr * 64);
          else    epi_inproj_n4(p, l, acc[0], m0 + wr * 64, nt128, wc, rsl_all + wr * 64);
        }
      }
      break;
    }
    if (!tile_of(it, NT, mt, nt)) break;
    const int m0 = mt * 256;
    const u16* Ap = A + (size_t)m0 * lda;
    if (kind != G_DOWN) {
      __syncthreads();
      if (ftid < 256) {
        const float4* rp = (const float4*)(rowss_in + (size_t)(m0 + ftid) * 16);
        const float4 a0 = rp[0], a1 = rp[1], a2 = rp[2], a3 = rp[3];
        float sm_ = ((a0.x + a0.y) + (a0.z + a0.w)) + ((a1.x + a1.y) + (a1.z + a1.w)) + ((a2.x + a2.y) + (a2.z + a2.w)) + ((a3.x + a3.y) + (a3.z + a3.w));
        rsl_all[ftid] = rsqrtf(sm_ * (1.f / 1024.f) + EPSV);
      }
    }
    if (kind == G_INPROJ) {
      const int wr = wid >> 2, wc = wid & 3;
      const int n0 = nt * 256;
      const int g64 = nt * 4 + wc, nt128 = g64 >> 1, wc64 = g64 & 1;
      const u16* Bp = Bt + (size_t)n0 * ldb;
      const bool m4 = (nt128 == 7 || nt128 == 9 || (nt128 >= 10 && nt128 < 22));
      if (m4) gemm_main8<true, true>(Ap, lda, Bp, ldb, K, sm, acc);
      else    gemm_main8<true, false>(Ap, lda, Bp, ldb, K, sm, acc);
      {
        const int lane_ = ftid & 63;
#pragma unroll
        for (int mf = 0; mf < 4; mf++)
#pragma unroll
          for (int nf = 0; nf < 4; nf++) *(f32x4*)(Tw + ((mf * 4 + nf) * 64 + lane_) * 4) = acc[1][mf][nf];
      }
#pragma unroll 1
      for (int h = 0; h < 2; h++) {
        if (h == 1) {
          const int lane_ = ftid & 63;
#pragma unroll
          for (int mf = 0; mf < 4; mf++)
#pragma unroll
            for (int nf = 0; nf < 4; nf++) acc[0][mf][nf] = *(const f32x4*)(Tw + ((mf * 4 + nf) * 64 + lane_) * 4);
        }
        if (nt128 < 27) {
          if (m4) epi_inproj_m4(p, l, acc[0], m0 + wr * 128 + h * 64, nt128, wc64, rsl_all + wr * 128 + h * 64);
          else    epi_inproj_n4(p, l, acc[0], m0 + wr * 128 + h * 64, nt128, wc64, rsl_all + wr * 128 + h * 64);
        }
      }
    } else {
      const int wr = wid >> 2, wc = wid & 3;
      const int n0 = nt * 256, nb = n0 + wc * 64;
      const u16* Bp = Bt + (size_t)n0 * ldb;
      gemm_main8<true, false>(Ap, lda, Bp, ldb, K, sm, acc);
#pragma unroll
      for (int h = 0; h < 2; h++) {
        const int mb = m0 + wr * 128 + h * 64;
        const float* rsl = rsl_all + wr * 128 + h * 64;
        if (kind == G_UP) epi_swiglu(acc[h], mb, nb, rsl, Hout);
        else epi_resid_lds(acc[h], mb, nb, scale, fin ? p.out : nullptr, (u16*)(p.ws + OFF_XB), rowss_out, Tw);
      }
      if (kind == G_DOWN) __syncthreads();
    }
  }
}

__device__ __forceinline__ float gelu_tanh(float x) {
  const float u = 0.7978845608028654f * (x + 0.044715f * x * x * x);
  const float e = __expf(2.f * u);
  const float th = 1.f - 2.f * __builtin_amdgcn_rcpf(e + 1.f);
  return 0.5f * x * (1.f + th);
}
__device__ void compress_item(const Params& p, int item, u16* hs) {
  unsigned char* ws = p.ws;
  const int tid_ = otid(); const int lane = tid_ & 63, w = tid_ >> 6, lr = lane & 15, quad = lane >> 4;
  const int kv = item & 1, bg = (item >> 1) & 7, ng = item >> 4, n0 = ng * 16;
  const u16* src = (const u16*)(ws + (kv ? OFF_VC : OFF_KC));
  const u16* w1T = (const u16*)(ws + OFF_CW1T) + (size_t)kv * 128 * 2048;
  const u16* w2T = (const u16*)(ws + OFF_CW2T) + (size_t)kv * 64 * 128;
  const float* bias = (const float*)(ws + OFF_CBP) + kv * 128;
  const int n = n0 + lr, nc = n < 254 ? n : 254;
  const u16* ap = src + ((size_t)bg * SL + nc * 16) * 64 + quad * 8;
  const u16* bp = w1T + (size_t)(w * 32 + lr) * 2048 + quad * 8;
  f32x4 a0 = {0, 0, 0, 0}, a1 = {0, 0, 0, 0};
#pragma unroll 8
  for (int k = 0; k < 64; k++) {
    bf16x8 a = *(const bf16x8*)(ap + k * 32);
    bf16x8 b0 = *(const bf16x8*)(bp + k * 32);
    bf16x8 b1 = *(const bf16x8*)(bp + 16 * 2048 + k * 32);
    a0 = mfma16(a, b0, a0);
    a1 = mfma16(a, b1, a1);
  }
  {
    const int e0 = w * 32 + lr, e1 = w * 32 + 16 + lr;
    float be0 = 0.f, be1 = 0.f;
#pragma unroll 8
    for (int bb = 0; bb < 16; bb++) { be0 += bias[bb * 256 + e0]; be1 += bias[bb * 256 + e1]; }
#pragma unroll
    for (int j = 0; j < 4; j++) {
      hs[(quad * 4 + j) * 136 + e0] = f2bf(gelu_tanh(a0[j] + be0));
      hs[(quad * 4 + j) * 136 + e1] = f2bf(gelu_tanh(a1[j] + be1));
    }
  }
  __syncthreads();
  f32x4 o = {0, 0, 0, 0};
#pragma unroll
  for (int ks = 0; ks < 4; ks++) {
    bf16x8 a = *(const bf16x8*)(hs + lr * 136 + ks * 32 + quad * 8);
    bf16x8 b = *(const bf16x8*)(w2T + (size_t)(w * 16 + lr) * 128 + ks * 32 + quad * 8);
    o = mfma16(a, b, o);
  }
  if (kv == 0) {
    u16* kcc = (u16*)(ws + OFF_KCC);
#pragma unroll
    for (int j = 0; j < 4; j++) {
      int nn = n0 + quad * 4 + j;
      kcc[((size_t)bg * 256 + nn) * 64 + w * 16 + lr] = f2bf(nn <= 254 ? o[j] : 0.f);
    }
  } else {
    u16* vccT = (u16*)(ws + OFF_VCCT);
    int nn = n0 + quad * 4;
    float o3 = (nn + 3 <= 254) ? o[3] : 0.f;
    *(uint2*)(vccT + ((size_t)bg * 64 + w * 16 + lr) * 256 + nn) = pk4(o[0], o[1], o[2], o3);
  }
  __syncthreads();
}

__device__ void cmpattn_stage(const Params& p, int bg, unsigned char* lds) {
  unsigned char* ws = p.ws;
  const int tid = otid();
  const u16* kcc = (const u16*)(ws + OFF_KCC) + (size_t)bg * 256 * 64;
  const u16* vT = (const u16*)(ws + OFF_VCCT) + (size_t)bg * 64 * 256;
#pragma unroll
  for (int i = 0; i < 8; i++) {
    const int c = tid + 256 * i, row = c >> 3, lc = (c & 7) ^ ((row >> 1) & 7);
    __builtin_amdgcn_global_load_lds((const unsigned*)(kcc + (size_t)row * 64 + lc * 8), (unsigned*)(lds + c * 16), 16, 0, 0);
  }
#pragma unroll
  for (int i = 0; i < 8; i++) {
    const int c = tid + 256 * i, row = c >> 5, lc = (c & 31) ^ (row & 15);
    __builtin_amdgcn_global_load_lds((const unsigned*)(vT + (size_t)row * 256 + lc * 8), (unsigned*)(lds + 32768 + c * 16), 16, 0, 0);
  }
  asm volatile("s_waitcnt vmcnt(0)" ::: "memory");
  __syncthreads();
}

__device__ void cmpattn_item(const Params& p, int bg, int tt, const unsigned char* lds, float* imp) {
  unsigned char* ws = p.ws;
  const int tid_ = otid(); const int lane = tid_ & 63, w = tid_ >> 6, lr = lane & 15, quad = lane >> 4;
  const int t0 = tt * 16;
  const int b = bg >> 1, g = bg & 1;
  const int t = t0 + 4 * w + (lr >> 2);
  const int head = g * 4 + (lr & 3);
  const u16* qp = (const u16*)(ws + OFF_Q) + ((size_t)(b * SL + t)) * 512 + head * 64 + quad * 8;
  const bf16x8 q0 = *(const bf16x8*)qp, q1 = *(const bf16x8*)(qp + 32);
  const int tmax = t0 + 4 * w + 3;
  const int nvm = tmax >= 31 ? ((tmax - 31) >> 4) + 1 : 0;
  const int nfrag = (nvm + 15) >> 4;
  const int ksw = (lr >> 1) & 7;
  const float mx = 0.f;
  f32x4 O[4];
#pragma unroll
  for (int df = 0; df < 4; df++) O[df] = f32x4{0.f, 0.f, 0.f, 0.f};
  float sum = 0.f, prev_sh = 0.f;
  const int ngp = (nfrag + 1) >> 1;
#pragma unroll 2
  for (int gp = 0; gp < 8; gp++) {
    float pr[2][4];
    if (gp < ngp) {
#pragma unroll
      for (int hf = 0; hf < 2; hf++) {
        const int f = 2 * gp + hf;
        const unsigned char* kp = lds + (f * 16 + lr) * 128;
        f32x4 sv = mfma16(*(const bf16x8*)(kp + ((quad ^ ksw) * 16)), q0, f32x4{0.f, 0.f, 0.f, 0.f});
        sv = mfma16(*(const bf16x8*)(kp + (((4 + quad) ^ ksw) * 16)), q1, sv);
#pragma unroll
        for (int j = 0; j < 4; j++) {
          const int n = f * 16 + quad * 4 + j;
          const float pv = (16 * n + 31 <= t) ? ex2(sv[j] - mx) : 0.f;
          pr[hf][j] = pv;
          sum += pv;
        }
      }
      const bf16x8 pf = mk8(pk4(pr[0][0], pr[0][1], pr[0][2], pr[0][3]), pk4(pr[1][0], pr[1][1], pr[1][2], pr[1][3]));
#pragma unroll
      for (int df = 0; df < 4; df++) {
        const unsigned char* vp = lds + 32768 + (df * 16 + lr) * 512 + (quad & 1) * 8;
        const bf16x8 vf = mk8(*(const uint2*)(vp + (((gp * 4 + (quad >> 1)) ^ lr) * 16)), *(const uint2*)(vp + (((gp * 4 + 2 + (quad >> 1)) ^ lr) * 16)));
        O[df] = mfma16(vf, pf, O[df]);
      }
    } else {
#pragma unroll
      for (int hf = 0; hf < 2; hf++)
#pragma unroll
        for (int j = 0; j < 4; j++) pr[hf][j] = 0.f;
    }
#pragma unroll
    for (int hf = 0; hf < 2; hf++) {
      const int f = 2 * gp + hf;
      const float sh = __shfl(pr[hf][3], (lane - 16) & 63);
      const float add = (quad == 0) ? prev_sh : sh;
      float bs = pr[hf][0] + pr[hf][1] + pr[hf][2] + pr[hf][3] + add;
      prev_sh = sh;
      bs += __shfl_xor(bs, 1);
      bs += __shfl_xor(bs, 2);
      if ((lr & 3) == 0) imp[(4 * w + (lr >> 2)) * 64 + 4 * f + quad] = bs;
    }
  }
  sum += __shfl_xor(sum, 16);
  sum += __shfl_xor(sum, 32);
  const float inv = sum > 0.f ? 1.f / sum : 0.f;
  {
    const float g0 = inv * ((const float*)(ws + OFF_GATES))[((size_t)(b * SL + t)) * 24 + head * 3 + 0];
    u16* mp = (u16*)(ws + OFF_MIX) + ((size_t)(b * SL + t)) * 1024 + head * 64 + quad * 4;
#pragma unroll
    for (int df = 0; df < 4; df++) *(uint2*)(mp + df * 16) = pk4(g0 * O[df][0], g0 * O[df][1], g0 * O[df][2], g0 * O[df][3]);
  }
  __syncthreads();
  u64* selp = (u64*)(ws + OFF_SEL) + (size_t)bg * SL;
#pragma unroll 1
  for (int tl = 0; tl < 4; tl++) {
    const int tok = 4 * w + tl, tq = t0 + tok, cur = tq >> 6, j = lane;
    const float raw = imp[tok * 64 + j];
    const float INFV = __builtin_inff();
    const float v = (j <= cur) ? ((j == 0 || j == cur || j == cur - 1) ? INFV : raw) : -INFV;
    int rank = 0;
    const int vbits = __builtin_bit_cast(int, v);
#pragma unroll
    for (int jj = 0; jj < 64; jj++) {
      const float vv = __builtin_bit_cast(float, __builtin_amdgcn_readlane(vbits, jj));
      rank += ((vv > v) || (vv == v && jj < j)) ? 1 : 0;
    }
    const bool selb = (j <= cur) && rank < 16;
    const u64 mk = __ballot(selb);
    if (lane == 0) selp[tq] = mk;
  }
  __syncthreads();
}

struct FlashState { f32x4 O[2][4]; float m[2], l[2]; };

__device__ __forceinline__ void flash_block(FlashState& fs, const bf16x8 (&qf)[2][2], const unsigned char* lK, const unsigned char* lV,
                                            int kb, bool win, bool fast, const int (&tq)[2], const u64 (&msk)[2]) {
  const int lane = otid() & 63, lr = lane & 15, quad = lane >> 4;
  const int sw = (lr >> 1) & 7;
  const unsigned kbase = (unsigned)(size_t)lK + lr * 128;
  const unsigned ka0 = kbase + ((quad ^ sw) * 16), ka1 = kbase + (((4 + quad) ^ sw) * 16);
  bf16x8 kf[4][2];
  kf[0][0] = ldsr128<0>(ka0); kf[1][0] = ldsr128<2048>(ka0); kf[2][0] = ldsr128<4096>(ka0); kf[3][0] = ldsr128<6144>(ka0);
  kf[0][1] = ldsr128<0>(ka1); kf[1][1] = ldsr128<2048>(ka1); kf[2][1] = ldsr128<4096>(ka1); kf[3][1] = ldsr128<6144>(ka1);
  asm volatile("s_waitcnt lgkmcnt(0)"
               : "+v"(kf[0][0]), "+v"(kf[1][0]), "+v"(kf[2][0]), "+v"(kf[3][0]), "+v"(kf[0][1]), "+v"(kf[1][1]), "+v"(kf[2][1]), "+v"(kf[3][1]));
  f32x4 s[2][4];
  __builtin_amdgcn_s_setprio(1);
#pragma unroll
  for (int rg = 0; rg < 2; rg++)
#pragma unroll
    for (int f = 0; f < 4; f++) {
      s[rg][f] = mfma16(kf[f][0], qf[rg][0], f32x4{0.f, 0.f, 0.f, 0.f});
      s[rg][f] = mfma16(kf[f][1], qf[rg][1], s[rg][f]);
    }
  __builtin_amdgcn_s_setprio(0);
  const unsigned vbase = (unsigned)(size_t)lV + lr * 128 + (quad & 1) * 8;
  const unsigned va0 = vbase + (((quad >> 1)) ^ sw) * 16, va1 = vbase + ((2 + (quad >> 1)) ^ sw) * 16;
  const unsigned va2 = vbase + ((4 + (quad >> 1)) ^ sw) * 16, va3 = vbase + ((6 + (quad >> 1)) ^ sw) * 16;
  uint2 vl[4][2], vh[4][2];
  vl[0][0] = ldsr64<0>(va0); vh[0][0] = ldsr64<0>(va1); vl[0][1] = ldsr64<0>(va2); vh[0][1] = ldsr64<0>(va3);
  vl[1][0] = ldsr64<2048>(va0); vh[1][0] = ldsr64<2048>(va1); vl[1][1] = ldsr64<2048>(va2); vh[1][1] = ldsr64<2048>(va3);
  vl[2][0] = ldsr64<4096>(va0); vh[2][0] = ldsr64<4096>(va1); vl[2][1] = ldsr64<4096>(va2); vh[2][1] = ldsr64<4096>(va3);
  vl[3][0] = ldsr64<6144>(va0); vh[3][0] = ldsr64<6144>(va1); vl[3][1] = ldsr64<6144>(va2); vh[3][1] = ldsr64<6144>(va3);
  bf16x8 pf[2][2];
  bf16x8 vf[4][2];
#pragma unroll
  for (int rg = 0; rg < 2; rg++) {
    const int t = tq[rg];
    const bool rowok = win ? true : (((msk[rg] >> kb) & 1ull) != 0);
    const int tlo = win ? t - 511 : 0;
    float ps = 0.f;
    if (fast) {
#pragma unroll
      for (int f = 0; f < 4; f++)
#pragma unroll
        for (int j = 0; j < 4; j++) {
          const float pv = ex2(rowok ? s[rg][f][j] : -1000.f);
          s[rg][f][j] = pv;
          ps += pv;
        }
    } else {
#pragma unroll
      for (int f = 0; f < 4; f++)
#pragma unroll
        for (int j = 0; j < 4; j++) {
          const int key = kb * 64 + f * 16 + quad * 4 + j;
          const bool ok = rowok && (key <= t) && (key >= tlo);
          const float pv = ex2(ok ? s[rg][f][j] : -1000.f);
          s[rg][f][j] = pv;
          ps += pv;
        }
    }
    fs.l[rg] += ps;
#pragma unroll
    for (int gp = 0; gp < 2; gp++)
      pf[rg][gp] = mk8(pk4(s[rg][2 * gp][0], s[rg][2 * gp][1], s[rg][2 * gp][2], s[rg][2 * gp][3]),
                       pk4(s[rg][2 * gp + 1][0], s[rg][2 * gp + 1][1], s[rg][2 * gp + 1][2], s[rg][2 * gp + 1][3]));
    if (rg == 0) {
      asm volatile("s_waitcnt lgkmcnt(0)"
                   : "+v"(vl[0][0]), "+v"(vh[0][0]), "+v"(vl[0][1]), "+v"(vh[0][1]), "+v"(vl[1][0]), "+v"(vh[1][0]), "+v"(vl[1][1]), "+v"(vh[1][1]),
                     "+v"(vl[2][0]), "+v"(vh[2][0]), "+v"(vl[2][1]), "+v"(vh[2][1]), "+v"(vl[3][0]), "+v"(vh[3][0]), "+v"(vl[3][1]), "+v"(vh[3][1]));
#pragma unroll
      for (int df = 0; df < 4; df++)
#pragma unroll
        for (int gp = 0; gp < 2; gp++) vf[df][gp] = mk8(vl[df][gp], vh[df][gp]);
    }
    __builtin_amdgcn_s_setprio(1);
#pragma unroll
    for (int df = 0; df < 4; df++)
#pragma unroll
      for (int gp = 0; gp < 2; gp++) fs.O[rg][df] = mfma16(vf[df][gp], pf[rg][gp], fs.O[rg][df]);
    __builtin_amdgcn_s_setprio(0);
  }
}

__device__ __forceinline__ void flash_reset(FlashState& fs) {
#pragma unroll
  for (int rg = 0; rg < 2; rg++) {
    fs.m[rg] = NEGB; fs.l[rg] = 0.f;
#pragma unroll
    for (int df = 0; df < 4; df++) fs.O[rg][df] = f32x4{0.f, 0.f, 0.f, 0.f};
  }
}

__device__ __forceinline__ void flash_commit(FlashState& fs, const float* gates, u16* mix, int b, int head, const int (&tq)[2], int gi) {
  const int lane = threadIdx.x & 63, quad = lane >> 4;
#pragma unroll
  for (int rg = 0; rg < 2; rg++) {
    float lsum = fs.l[rg];
    lsum += __shfl_xor(lsum, 16);
    lsum += __shfl_xor(lsum, 32);
    const float gg = gates[((size_t)(b * SL + tq[rg])) * 24 + head * 3 + gi];
    const float sc = gg / lsum;
    u16* mp = mix + ((size_t)(b * SL + tq[rg])) * 1024 + head * 64 + quad * 4;
    uint2 pvv[4];
#pragma unroll
    for (int df = 0; df < 4; df++) pvv[df] = *(const uint2*)(mp + df * 16);
#pragma unroll
    for (int df = 0; df < 4; df++) {
      const uint2 pv = pvv[df];
      const float c0 = bf2f((u16)(pv.x & 0xffff)), c1 = bf2f((u16)(pv.x >> 16)), c2 = bf2f((u16)(pv.y & 0xffff)), c3 = bf2f((u16)(pv.y >> 16));
      *(uint2*)(mp + df * 16) = pk4(fs.O[rg][df][0] * sc + c0, fs.O[rg][df][1] * sc + c1, fs.O[rg][df][2] * sc + c2, fs.O[rg][df][3] * sc + c3);
    }
  }
}

__device__ void nsa_attn_item(const Params& p, int item, unsigned char* lds, volatile int* totx) {
  unsigned char* ws = p.ws;
  const int tid = otid(), lane = tid & 63, w = tid >> 6, lr = lane & 15, quad = lane >> 4;
  const int bg = item & 7, ti = item >> 3, t0 = ti * 32;
  const int b = bg >> 1, g = bg & 1, head = g * 4 + w;
  bf16x8 qf[2][2];
  int tq[2];
#pragma unroll
  for (int rg = 0; rg < 2; rg++) {
    tq[rg] = t0 + rg * 16 + lr;
    const u16* qp = (const u16*)(ws + OFF_Q) + ((size_t)(b * SL + tq[rg])) * 512 + head * 64 + quad * 8;
    qf[rg][0] = *(const bf16x8*)qp;
    qf[rg][1] = *(const bf16x8*)(qp + 32);
  }
  const u64* selp = (const u64*)(ws + OFF_SEL) + (size_t)bg * SL;
  u64 msk[2] = {selp[tq[0]], selp[tq[1]]};
  unsigned ulo = (unsigned)(msk[0] | msk[1]), uhi = (unsigned)((msk[0] | msk[1]) >> 32);
#pragma unroll
  for (int o = 1; o < 16; o <<= 1) { ulo |= __shfl_xor(ulo, o); uhi |= __shfl_xor(uhi, o); }
  ulo = __builtin_amdgcn_readfirstlane(ulo);
  uhi = __builtin_amdgcn_readfirstlane(uhi);
  u64 un = ((u64)uhi << 32) | ulo;
  const int nsel = __builtin_popcountll(un);
  const int wlo = t0 - 511 > 0 ? (t0 - 511) >> 6 : 0;
  const int whi = (t0 + 31) >> 6;
  const int total = nsel + (whi - wlo + 1);
  const u16* Ks = (const u16*)(ws + OFF_KS) + (size_t)bg * SL * 64;
  const u16* Vs = (const u16*)(ws + OFF_VST) + (size_t)bg * 64 * SL;
  const u16* Kw = (const u16*)(ws + OFF_KW) + (size_t)bg * SL * 64;
  const u16* Vw = (const u16*)(ws + OFF_VWT) + (size_t)bg * 64 * SL;
  const int drow = tid >> 3, dlc = (tid & 7) ^ ((drow >> 1) & 7);
#define ATT_ISSUE(stage, Kp, Vp, kb_)                                                                                  \
  do {                                                                                                                 \
    _Pragma("unroll") for (int i_ = 0; i_ < 2; i_++) {                                                                 \
      __builtin_amdgcn_global_load_lds((const unsigned*)((Kp) + ((size_t)((kb_) * 64 + drow + 32 * i_)) * 64 + dlc * 8), \
                                       (unsigned*)(lds + (stage) * 16384 + (tid + 256 * i_) * 16), 16, 0, 0);          \
      __builtin_amdgcn_global_load_lds((const unsigned*)((Vp) + (size_t)(drow + 32 * i_) * SL + (kb_) * 64 + dlc * 8), \
                                       (unsigned*)(lds + (stage) * 16384 + 8192 + (tid + 256 * i_) * 16), 16, 0, 0);   \
    }                                                                                                                  \
  } while (0)
  const int npairs = (total + 1) >> 1;
  {
    const int half_ = ohalf();
    if (tid == 0) totx[half_] = npairs;
    __syncthreads();
  }
  const int tmaxb = totx[0] > totx[1] ? totx[0] : totx[1];
  FlashState fs;
  const float* gp_ = (const float*)(ws + OFF_GATES);
  flash_reset(fs);
  u64 rem_i = un;
  int ii = 0;
#define ATT_ISSUE_NEXT(slot)                                                                 \
  do {                                                                                       \
    if (ii < total) {                                                                        \
      if (ii < nsel) { const int kb_ = __builtin_ctzll(rem_i); rem_i &= rem_i - 1; ATT_ISSUE(slot, Ks, Vs, kb_); } \
      else { const int kb_ = wlo + (ii - nsel); ATT_ISSUE(slot, Kw, Vw, kb_); }              \
      ii++;                                                                                  \
    }                                                                                        \
  } while (0)
  ATT_ISSUE_NEXT(0);
  ATT_ISSUE_NEXT(1);
  u64 rem_c = un;
#pragma unroll 1
  for (int pi = 0; pi < tmaxb; pi++) {
    asm volatile("s_waitcnt vmcnt(0)" ::: "memory");
    __builtin_amdgcn_s_barrier();
    __builtin_amdgcn_sched_barrier(0);
    if (pi >= npairs) continue;
    const int sbase = (pi & 1) * 2;
    ATT_ISSUE_NEXT((sbase ^ 2));
    ATT_ISSUE_NEXT((sbase ^ 2) + 1);
#pragma unroll 1
    for (int sub = 0; sub < 2; sub++) {
      const int i = 2 * pi + sub;
      if (i >= total) break;
      int kb_cur;
      if (i < nsel) { kb_cur = __builtin_ctzll(rem_c); rem_c &= rem_c - 1; }
      else kb_cur = wlo + (i - nsel);
      if (i == nsel) {
        flash_commit(fs, gp_, (u16*)(ws + OFF_MIX), b, head, tq, 1);
        flash_reset(fs);
      }
      const unsigned char* lK = lds + (sbase + sub) * 16384;
      const bool winb = i >= nsel;
      const bool fast = winb ? ((kb_cur * 64 >= t0 + 31 - 511) && (kb_cur * 64 + 63 <= t0)) : (kb_cur < (t0 >> 6));
      flash_block(fs, qf, lK, lK + 8192, kb_cur, winb, fast, tq, msk);
    }
  }
#undef ATT_ISSUE_NEXT
  flash_commit(fs, gp_, (u16*)(ws + OFF_MIX), b, head, tq, 2);
  __syncthreads();
#undef ATT_ISSUE
}

__device__ void hgrn_u_item(const Params& p, int item) {
  unsigned char* ws = p.ws;
  const int tid_ = otid(); const int lane = tid_ & 63, w = tid_ >> 6, lr = lane & 15, quad = lane >> 4;
  const int bh = item >> 6, c = item & 63, b = bh >> 2, h = bh & 3;
  const size_t tokb = (size_t)b * SL + c * 64;
  const u16* ktT = (const u16*)(ws + OFF_KTT);
  const u16* vhT = (const u16*)(ws + OFF_VHT);
  f32x4 acc[2][8];
#pragma unroll
  for (int i = 0; i < 2; i++)
#pragma unroll
    for (int d = 0; d < 8; d++) acc[i][d] = f32x4{0.f, 0.f, 0.f, 0.f};
#pragma unroll
  for (int ks = 0; ks < 2; ks++) {
    bf16x8 a[2];
#pragma unroll
    for (int i = 0; i < 2; i++) a[i] = *(const bf16x8*)(ktT + (size_t)(h * 128 + (2 * w + i) * 16 + lr) * MT + tokb + ks * 32 + quad * 8);
#pragma unroll
    for (int d = 0; d < 8; d++) {
      const bf16x8 bv = *(const bf16x8*)(vhT + (size_t)(h * 128 + d * 16 + lr) * MT + tokb + ks * 32 + quad * 8);
#pragma unroll
      for (int i = 0; i < 2; i++) acc[i][d] = mfma16(a[i], bv, acc[i][d]);
    }
  }
  u16* US = (u16*)p.out;
#pragma unroll
  for (int i = 0; i < 2; i++)
#pragma unroll
    for (int d = 0; d < 8; d++)
      *(uint2*)(US + ((size_t)(bh * 64 + c) * 128 + d * 16 + lr) * 128 + (2 * w + i) * 16 + quad * 4) =
          pk4(acc[i][d][0], acc[i][d][1], acc[i][d][2], acc[i][d][3]);
}

__device__ void hgrn_scan_item(const Params& p, int item) {
  unsigned char* ws = p.ws;
  const int gidx = item * 256 + otid();
  const int bh = gidx >> 13, dv = (gidx >> 6) & 127, dk = (gidx & 63) * 2, b = bh >> 2, h = bh & 3;
  unsigned* up = (unsigned*)((u16*)p.out + ((size_t)bh * 64 * 128 + dv) * 128 + dk);
  const size_t foff = (size_t)(b * 64) * 512 + h * 128 + dk;
  const float* pem = (const float*)(ws + OFF_CVEM) + foff;
  const float* pdl = (const float*)(ws + OFF_CVDL) + foff;
  const float* pe1 = (const float*)(ws + OFF_CVE1) + foff;
  float S0 = 0.f, S1 = 0.f;
  unsigned ua[8], ub[8];
  float2 ema[8], dla[8], e1a[8], emb[8], dlb[8], e1b[8];
#pragma unroll
  for (int i = 0; i < 8; i++) {
    ua[i] = up[(size_t)i * 8192];
    ema[i] = *(const float2*)(pem + i * 512); dla[i] = *(const float2*)(pdl + i * 512); e1a[i] = *(const float2*)(pe1 + i * 512);
  }
#pragma unroll 1
  for (int g = 0; g < 8; g++) {
    if (g < 7) {
#pragma unroll
      for (int i = 0; i < 8; i++) {
        const int c = (g + 1) * 8 + i;
        ub[i] = up[(size_t)c * 8192];
        emb[i] = *(const float2*)(pem + c * 512); dlb[i] = *(const float2*)(pdl + c * 512); e1b[i] = *(const float2*)(pe1 + c * 512);
      }
    }
#pragma unroll
    for (int i = 0; i < 8; i++) {
      const int c = g * 8 + i;
      const float u0 = bf2f((u16)(ua[i] & 0xffff)), u1 = bf2f((u16)(ua[i] >> 16));
      up[(size_t)c * 8192] = pk2(ema[i].x * S0, ema[i].y * S1);
      S0 = dla[i].x * S0 + e1a[i].x * u0;
      S1 = dla[i].y * S1 + e1a[i].y * u1;
    }
#pragma unroll
    for (int i = 0; i < 8; i++) { ua[i] = ub[i]; ema[i] = emb[i]; dla[i] = dlb[i]; e1a[i] = e1b[i]; }
  }
}

__device__ void hgrn_out_item(const Params& p, int l, int item, u16* lds) {
  unsigned char* ws = p.ws;
  const int tid = otid(), lane = tid & 63, w = tid >> 6, lr = lane & 15, quad = lane >> 4;
  const int bh = item >> 6, c = item & 63, b = bh >> 2, h = bh & 3;
  const size_t tokb = (size_t)b * SL + c * 64;
  const u16* qtT = (const u16*)(ws + OFF_QTT);
  const u16* ktT = (const u16*)(ws + OFF_KTT);
  u16* lq = lds;
  u16* lk = lds + 128 * 68;
  uint4 vqa[4], vka[4];
#pragma unroll
  for (int i = 0; i < 4; i++) {
    const int cid = tid + 256 * i, row = cid >> 3, c8 = (cid & 7) * 8;
    vqa[i] = *(const uint4*)(qtT + (size_t)(h * 128 + row) * MT + tokb + c8);
    vka[i] = *(const uint4*)(ktT + (size_t)(h * 128 + row) * MT + tokb + c8);
  }
#pragma unroll
  for (int i = 0; i < 4; i++) {
    const int cid = tid + 256 * i, row = cid >> 3, c8 = (cid & 7) * 8;
    unsigned* dq = (unsigned*)(lq + row * 68 + c8);
    unsigned* dk = (unsigned*)(lk + row * 68 + c8);
    dq[0] = vqa[i].x; dq[1] = vqa[i].y; dq[2] = vqa[i].z; dq[3] = vqa[i].w;
    dk[0] = vka[i].x; dk[1] = vka[i].y; dk[2] = vka[i].z; dk[3] = vka[i].w;
  }
  __syncthreads();
  const unsigned trq = (unsigned)(size_t)lq + ((quad * 8 + (lr >> 2)) * 68 + 16 * w + 4 * (lr & 3)) * 2;
  bf16x8 qB[4];
  {
    uint2 a0 = ldstr64<0>(trq), b0 = ldstr64<544>(trq), a1 = ldstr64<4352>(trq), b1 = ldstr64<4352 + 544>(trq);
    uint2 a2 = ldstr64<8704>(trq), b2 = ldstr64<8704 + 544>(trq), a3 = ldstr64<13056>(trq), b3 = ldstr64<13056 + 544>(trq);
    asm volatile("s_waitcnt lgkmcnt(0)" : "+v"(a0), "+v"(b0), "+v"(a1), "+v"(b1), "+v"(a2), "+v"(b2), "+v"(a3), "+v"(b3));
    qB[0] = mk8(a0, b0); qB[1] = mk8(a1, b1); qB[2] = mk8(a2, b2); qB[3] = mk8(a3, b3);
  }
  const unsigned trk = (unsigned)(size_t)lk + ((quad * 8 + (lr >> 2)) * 68 + 4 * (lr & 3)) * 2;
  f32x4 D1[4];
#pragma unroll
  for (int sf = 0; sf < 4; sf++) {
    D1[sf] = f32x4{0.f, 0.f, 0.f, 0.f};
    if (sf <= w) {
      {
        const unsigned ak = trk + sf * 32;
        uint2 a0 = ldstr64<0>(ak), b0 = ldstr64<544>(ak), a1 = ldstr64<4352>(ak), b1 = ldstr64<4352 + 544>(ak);
        uint2 a2 = ldstr64<8704>(ak), b2 = ldstr64<8704 + 544>(ak), a3 = ldstr64<13056>(ak), b3 = ldstr64<13056 + 544>(ak);
        asm volatile("s_waitcnt lgkmcnt(0)" : "+v"(a0), "+v"(b0), "+v"(a1), "+v"(b1), "+v"(a2), "+v"(b2), "+v"(a3), "+v"(b3));
        D1[sf] = mfma16(mk8(a0, b0), qB[0], D1[sf]);
        D1[sf] = mfma16(mk8(a1, b1), qB[1], D1[sf]);
        D1[sf] = mfma16(mk8(a2, b2), qB[2], D1[sf]);
        D1[sf] = mfma16(mk8(a3, b3), qB[3], D1[sf]);
      }
    }
    const int tt = 16 * w + lr;
#pragma unroll
    for (int j = 0; j < 4; j++) {
      const int s_ = sf * 16 + quad * 4 + j;
      if (s_ > tt) D1[sf][j] = 0.f;
    }
  }
  bf16x8 pB[2];
#pragma unroll
  for (int gp = 0; gp < 2; gp++)
    pB[gp] = mk8(pk4(D1[2 * gp][0], D1[2 * gp][1], D1[2 * gp][2], D1[2 * gp][3]),
                 pk4(D1[2 * gp + 1][0], D1[2 * gp + 1][1], D1[2 * gp + 1][2], D1[2 * gp + 1][3]));
  const u16* vhT = (const u16*)(ws + OFF_VHT);
  const u16* US = (const u16*)p.out;
  f32x4 o[8];
#pragma unroll
  for (int d = 0; d < 8; d++) {
    o[d] = f32x4{0.f, 0.f, 0.f, 0.f};
    const u16* vp = vhT + (size_t)(h * 128 + d * 16 + lr) * MT + tokb + quad * 4;
#pragma unroll
    for (int gp = 0; gp < 2; gp++) {
      if (gp * 2 <= w) {
        const bf16x8 vf = mk8(*(const uint2*)(vp + gp * 32), *(const uint2*)(vp + gp * 32 + 16));
        o[d] = mfma16(vf, pB[gp], o[d]);
      }
    }
    const u16* sp = US + ((size_t)(bh * 64 + c) * 128 + d * 16 + lr) * 128 + quad * 8;
#pragma unroll
    for (int ks = 0; ks < 4; ks++) o[d] = mfma16(*(const bf16x8*)(sp + ks * 32), qB[ks], o[d]);
    if (d & 1) __builtin_amdgcn_sched_barrier(0);
  }
  float ss = 0.f;
#pragma unroll
  for (int d = 0; d < 8; d++)
#pragma unroll
    for (int j = 0; j < 4; j++) ss += o[d][j] * o[d][j];
  ss += __shfl_xor(ss, 16);
  ss += __shfl_xor(ss, 32);
  const float r = rsqrtf(ss * (1.f / 128.f) + EPSV);
  const size_t m = tokb + 16 * w + lr;
  const u16* hgp = (const u16*)(ws + OFF_HG) + m * 512 + h * 128 + quad * 4;
  const float* og = p.out_norm + l * 128 + quad * 4;
  u16* mp = (u16*)(ws + OFF_MIX) + m * 1024 + 512 + h * 128 + quad * 4;
  uint2 hvv[8];
#pragma unroll
  for (int d = 0; d < 8; d++) hvv[d] = *(const uint2*)(hgp + d * 16);
#pragma unroll
  for (int d = 0; d < 8; d++) {
    const uint2 hv = hvv[d];
    const float4 g4 = *(const float4*)(og + d * 16);
    const float h0 = bf2f((u16)(hv.x & 0xffff)), h1 = bf2f((u16)(hv.x >> 16)), h2 = bf2f((u16)(hv.y & 0xffff)), h3 = bf2f((u16)(hv.y >> 16));
    *(uint2*)(mp + d * 16) = pk4(o[d][0] * r * g4.x * siluf_(h0), o[d][1] * r * g4.y * siluf_(h1),
                                 o[d][2] * r * g4.z * siluf_(h2), o[d][3] * r * g4.w * siluf_(h3));
  }
  __syncthreads();
}

__global__ void __launch_bounds__(512, 2) fwd_mega(Params p) {
  __shared__ __attribute__((aligned(16))) unsigned char smem[2 * 73728 + 1024];
  __shared__ unsigned xbst[2];
  __shared__ int totx[2];
  unsigned char* ws = p.ws;
  XcdBarrier gb;
  gb.bar = (unsigned*)(ws + OFF_CTL); gb.x = xb_xcc_id(); gb.st = xbst;
  if (threadIdx.x == 0) { xbst[0] = 0u; xbst[1] = 0u; (void)xb_add(&gb.bar[XB_XCNT(gb.x)], 1u); }
  __syncthreads();
  if (p.never) cg::this_grid().sync();
  const int half = ohalf();
  const int G = gridDim.x * 2, bid = blockIdx.x * 2 + half;
  unsigned char* hsm = smem + half * 73728;
  float* rowss = (float*)(ws + OFF_ROWSS);
  u16* xb = (u16*)(ws + OFF_XB);
  u16* Hb = (u16*)(ws + OFF_H);
  u16* mix = (u16*)(ws + OFF_MIX);

  phase_init(p);
#pragma unroll 1
  for (int l = 0; l < 2; l++) {
    phase_convert(p, l, (float*)smem);
    grid_bar(gb);
    phase_gemm(p, l, G_UP, xb, DM, (const u16*)(ws + OFF_WGU1), DM, DM, 22, rowss + (size_t)(3 * l) * MT * 16, nullptr, 0.f, Hb, (u16*)smem);
    grid_bar(gb);
    phase_gemm(p, l, G_DOWN, Hb, DFF, (const u16*)(ws + OFF_WD1), DFF, DFF, 4, nullptr, rowss + (size_t)(3 * l + 1) * MT * 16, 0.5f, nullptr, (u16*)smem);
    grid_bar(gb);
    phase_gemm(p, l, G_INPROJ, xb, DM, (const u16*)(ws + OFF_WIN), DM, DM, 14, rowss + (size_t)(3 * l + 1) * MT * 16, nullptr, 0.f, nullptr, (u16*)smem);
    grid_bar(gb);
    if (bid < 256) {
      compress_item(p, bid, (u16*)hsm);
      hgrn_u_item(p, bid);
    } else {
#pragma unroll 1
      for (int k = 0; k < 3; k++) hgrn_u_item(p, 256 + (bid - 256) * 3 + k);
    }
    grid_bar(gb);
    {
      const int bgc = bid >> 6;
      cmpattn_stage(p, bgc, hsm);
#pragma unroll 1
      for (int k = 0; k < 4; k++) cmpattn_item(p, bgc, (bid & 63) + 64 * k, hsm, (float*)(hsm + 65536));
      hgrn_scan_item(p, bid);
    }
    grid_bar(gb);
    for (int pass = 0;; pass++) {
      const int base = pass * G;
      if (base >= 1024) break;
      const int it = (pass & 1) ? (base + G - 1 - bid) : (base + bid);
      nsa_attn_item(p, it, hsm, totx);
    }
    for (int it = bid; it < 1024; it += G) hgrn_out_item(p, l, it, (u16*)hsm);
    grid_bar(gb);
    phase_gemm(p, l, G_DOWN, mix, DM, (const u16*)(ws + OFF_WOUT), DM, DM, 4, nullptr, rowss + (size_t)(3 * l + 2) * MT * 16, 1.0f, nullptr, (u16*)smem);
    grid_bar(gb);
    phase_gemm(p, l, G_UP, xb, DM, (const u16*)(ws + OFF_WGU2), DM, DM, 22, rowss + (size_t)(3 * l + 2) * MT * 16, nullptr, 0.f, Hb, (u16*)smem);
    grid_bar(gb);
    phase_gemm(p, l, G_DOWN, Hb, DFF, (const u16*)(ws + OFF_WD2), DFF, DFF, 4, nullptr, rowss + (size_t)(3 * l + 3) * MT * 16, 0.5f, nullptr, (u16*)smem, l == 1);
    grid_bar(gb);
  }
}

extern "C" void kernel_launch(void* const* d_in, const int* in_sizes, int n_in, void* d_out, int out_size, void* d_ws,
                              size_t ws_size, hipStream_t stream) {
  static int grid_blocks = 0;
  if (!grid_blocks) {
    int dev = 0, cus = 0, per_cu = 0;
    hipGetDevice(&dev);
    hipDeviceGetAttribute(&cus, hipDeviceAttributeMultiprocessorCount, dev);
    hipOccupancyMaxActiveBlocksPerMultiprocessor(&per_cu, fwd_mega, 512, 0);
    if (per_cu > 1) per_cu = 1;
    if (per_cu < 1) per_cu = 1;
    grid_blocks = cus * per_cu;
    grid_blocks -= grid_blocks % 8;
  }
  Params p{};
  const float* const* in = (const float* const*)d_in;
  p.x = in[0]; p.ffn1_norm = in[1]; p.ffn1_wg = in[2]; p.ffn1_wu = in[3]; p.ffn1_wd = in[4]; p.mix_norm = in[5];
  p.w_in = in[6]; p.q_norm = in[7]; p.k_norm = in[8]; p.cmp_pos = in[9]; p.cmp_w1 = in[10]; p.cmp_w2 = in[11];
  p.lb_logits = in[12]; p.out_norm = in[13]; p.w_out = in[14]; p.ffn2_norm = in[15]; p.ffn2_wg = in[16];
  p.ffn2_wu = in[17]; p.ffn2_wd = in[18];
  p.out = (float*)d_out;
  p.ws = (unsigned char*)d_ws;
  p.never = 0;
  p.pad = 0;
  hipMemsetAsync(d_ws, 0, 16384, stream);
  void* args[] = {&p};
  hipError_t e = hipLaunchCooperativeKernel((void*)fwd_mega, dim3(grid_blocks), dim3(512), args, 0, stream);
  if (e != hipSuccess) fprintf(stderr, "cooperative launch failed: %s (grid %d)\n", hipGetErrorString(e), grid_blocks);
}
```

```cpp
#include <hip/hip_runtime.h>
#include <hip/hip_cooperative_groups.h>
#include <cstdio>
#include <cstdint>
namespace cg = cooperative_groups;

typedef unsigned short u16;
typedef unsigned long long u64;
typedef __attribute__((ext_vector_type(8))) short bf16x8;
typedef __attribute__((ext_vector_type(4))) float f32x4;
typedef float f32x2_t __attribute__((ext_vector_type(2)));
typedef __bf16 bf16x2_t __attribute__((ext_vector_type(2)));

constexpr int MT = 16384;
constexpr int SL = 4096;
constexpr int DM = 1024;
constexpr int DFF = 2816;
constexpr int NINP = 3456;
constexpr float EPSV = 1e-6f;
constexpr float SCL2 = 0.125f * 1.4426950408889634f;
constexpr float NEGB = -1e30f;
constexpr float MASKV = -3.0e38f;

constexpr size_t MiB = 1u << 20;
constexpr size_t OFF_CTL   = 0;
constexpr size_t OFF_ROWSS = 220 * MiB;
constexpr size_t OFF_COS   = 16384;
constexpr size_t OFF_SIN   = OFF_COS + 524288;
constexpr size_t OFF_LB    = OFF_SIN + 524288;
constexpr size_t OFF_CBIAS = OFF_LB + 4096;
constexpr size_t OFF_CW2T  = OFF_CBIAS + 1024;
constexpr size_t OFF_CVEM  = OFF_CW2T + 32768;
constexpr size_t OFF_CVDL  = OFF_CVEM + 524288;
constexpr size_t OFF_CVE1  = OFF_CVDL + 524288;
constexpr size_t OFF_KCC   = OFF_CVE1 + 524288;
constexpr size_t OFF_VCCT  = OFF_KCC + 262144;
constexpr size_t OFF_SEL   = OFF_VCCT + 262144;
constexpr size_t OFF_GATES = OFF_SEL + 262144;
constexpr size_t OFF_CBP   = 5 * MiB;
constexpr size_t OFF_CW1T  = 6 * MiB;
constexpr size_t OFF_WGU1  = 7 * MiB;
constexpr size_t OFF_WD1   = 18 * MiB;
constexpr size_t OFF_WIN   = 24 * MiB;
constexpr size_t OFF_WOUT  = 31 * MiB;
constexpr size_t OFF_WGU2  = 33 * MiB;
constexpr size_t OFF_WD2   = 44 * MiB;
constexpr size_t OFF_XB    = 50 * MiB;
constexpr size_t OFF_US    = OFF_XB;
constexpr size_t OFF_MIX   = 82 * MiB;
constexpr size_t OFF_R     = 114 * MiB;
constexpr size_t OFF_H     = OFF_R;
constexpr size_t OFF_Q     = OFF_R;
constexpr size_t OFF_KC    = OFF_R + 16 * MiB;
constexpr size_t OFF_VC    = OFF_R + 20 * MiB;
constexpr size_t OFF_KS    = OFF_R + 24 * MiB;
constexpr size_t OFF_VST   = OFF_R + 28 * MiB;
constexpr size_t OFF_KW    = OFF_R + 32 * MiB;
constexpr size_t OFF_VWT   = OFF_R + 36 * MiB;
constexpr size_t OFF_QTT   = OFF_R + 40 * MiB;
constexpr size_t OFF_KTT   = OFF_R + 56 * MiB;
constexpr size_t OFF_VHT   = OFF_R + 72 * MiB;
constexpr size_t OFF_HG    = OFF_R + 88 * MiB;

struct Params {
  const float *x, *ffn1_norm, *ffn1_wg, *ffn1_wu, *ffn1_wd, *mix_norm, *w_in, *q_norm, *k_norm,
      *cmp_pos, *cmp_w1, *cmp_w2, *lb_logits, *out_norm, *w_out, *ffn2_norm, *ffn2_wg, *ffn2_wu, *ffn2_wd;
  float* out;
  unsigned char* ws;
  int never;
  int pad;
};

__device__ __forceinline__ unsigned pk2(float lo, float hi) {
  f32x2_t v = {lo, hi};
  bf16x2_t b = __builtin_convertvector(v, bf16x2_t);
  return __builtin_bit_cast(unsigned, b);
}
__device__ __forceinline__ u16 f2bf(float f) { return (u16)(pk2(f, 0.f) & 0xffffu); }
__device__ __forceinline__ float bf2f(u16 v) { return __builtin_bit_cast(float, ((unsigned)v) << 16); }
__device__ __forceinline__ uint2 pk4(float a, float b, float c, float d) { return make_uint2(pk2(a, b), pk2(c, d)); }
__device__ __forceinline__ f32x4 mfma16(bf16x8 a, bf16x8 b, f32x4 c) {
  return __builtin_amdgcn_mfma_f32_16x16x32_bf16(a, b, c, 0, 0, 0);
}
__device__ __forceinline__ bf16x8 mk8(uint2 lo, uint2 hi) {
  uint4 v = make_uint4(lo.x, lo.y, hi.x, hi.y);
  return __builtin_bit_cast(bf16x8, v);
}
__device__ __forceinline__ float sigmoidf_(float x) { return __builtin_amdgcn_rcpf(1.f + __expf(-x)); }
__device__ __forceinline__ float siluf_(float x) { return x * __builtin_amdgcn_rcpf(1.f + __expf(-x)); }
__device__ __forceinline__ float ex2(float x) { return __builtin_amdgcn_exp2f(x); }

__device__ __forceinline__ int ofull() { int t = threadIdx.x; asm volatile("" : "+v"(t)); return t; }
__device__ __forceinline__ int otid() { return ofull() & 255; }
__device__ __forceinline__ int ohalf() { return __builtin_amdgcn_readfirstlane(ofull() >> 8); }
__device__ __forceinline__ int obid() { int t = blockIdx.x; asm volatile("" : "+s"(t)); return t; }
#define XB_TMO      128
#define XB_XCNT(j)  (256  + 64 * (j))
#define XB_XSUB(j)  (1280 + 64 * (j))
#define XB_XGEN(j)  (2304 + 64 * (j))
#define XB_TOP      3328
#define XB_TOPGEN   3392
#define XB_SPIN_CAP (1u << 20)
__device__ __forceinline__ unsigned xb_ld(unsigned* p) { return __hip_atomic_load(p, __ATOMIC_RELAXED, __HIP_MEMORY_SCOPE_AGENT); }
__device__ __forceinline__ unsigned xb_add(unsigned* p, unsigned v) { return __hip_atomic_fetch_add(p, v, __ATOMIC_RELAXED, __HIP_MEMORY_SCOPE_AGENT); }
__device__ __forceinline__ unsigned xb_xcc_id() { return (unsigned)__builtin_amdgcn_s_getreg((3 << 11) | 20) & 0xFu; }
#define XB_SPIN(cond, bar) do { unsigned _sp = 0; while (cond) { __builtin_amdgcn_s_sleep(1); \
    if ((++_sp & 255u) == 0u) { if (xb_ld(&(bar)[XB_TMO])) break; if (_sp > XB_SPIN_CAP) { atomicAdd(&(bar)[XB_TMO], 1u); break; } } } } while (0)
struct XcdBarrier { unsigned* bar; unsigned x; volatile unsigned* st; };
__device__ __forceinline__ void xcd_barrier_complete(unsigned* bar, unsigned x, unsigned& nloc, unsigned& nx) {
  const unsigned G = gridDim.x;
  unsigned sum, cnt, mine, sp = 0u;
  for (;;) {
    sum = 0u; cnt = 0u; mine = 0u;
#pragma unroll
    for (unsigned j = 0; j < 16; ++j) { const unsigned c = xb_ld(&bar[XB_XCNT(j)]); sum += c; cnt += (c > 0u) ? 1u : 0u; mine = (j == x) ? c : mine; }
    if (sum == G) break;
    __builtin_amdgcn_s_sleep(1);
    if ((++sp & 255u) == 0u) { if (xb_ld(&bar[XB_TMO])) break; if (sp > XB_SPIN_CAP) { atomicAdd(&bar[XB_TMO], 1u); break; } }
  }
  nloc = mine > 0u ? mine : 1u; nx = cnt > 0u ? cnt : 1u;
}
__device__ __forceinline__ void grid_bar(const XcdBarrier& b) {
  asm volatile("s_waitcnt vmcnt(0)" ::: "memory");
  __syncthreads();
  if (threadIdx.x == 0) {
    unsigned* bar = b.bar;
    __builtin_amdgcn_s_waitcnt(0);
    unsigned nloc = b.st[0], nx = b.st[1];
    if (nloc == 0u) { xcd_barrier_complete(bar, b.x, nloc, nx); b.st[0] = nloc; b.st[1] = nx; }
    const unsigned old = xb_add(&bar[XB_XSUB(b.x)], 1u);
    const unsigned gen = old / nloc;
    if (old + 1u == (gen + 1u) * nloc) {
      __builtin_amdgcn_fence(__ATOMIC_RELEASE, "agent");
      asm volatile("s_waitcnt vmcnt(0)" ::: "memory");
      const unsigned og = xb_add(&bar[XB_TOP], 1u);
      const unsigned tg = og / nx;
      if (og + 1u == (tg + 1u) * nx) xb_add(&bar[XB_TOPGEN], 1u);
      else XB_SPIN(xb_ld(&bar[XB_TOPGEN]) == tg, bar);
      __builtin_amdgcn_fence(__ATOMIC_ACQUIRE, "agent");
      xb_add(&bar[XB_XGEN(b.x)], 1u);
      asm volatile("s_waitcnt vmcnt(0)" ::: "memory");
    } else {
      XB_SPIN(xb_ld(&bar[XB_XGEN(b.x)]) == gen, bar);
      __builtin_amdgcn_fence(__ATOMIC_ACQUIRE, "agent");
      asm volatile("s_waitcnt vmcnt(0)" ::: "memory");
    }
  }
  __syncthreads();
}

__device__ __forceinline__ const float* conv_src(int type, int r, const float* s0, const float* s1) {
  if (type == 0) return s0 + r;
  if (type == 1) { int grp = r >> 5, w = r & 31; int h = grp * 16 + (w & 15); return (w < 16 ? s0 : s1) + h; }
  if (r < 1280) return s0 + r;
  if (r < 2304) { int rr = r - 1280; int grp = rr >> 5, w = rr & 31; int ch = grp * 16 + (w & 15); return s0 + 1304 + (w < 16 ? 0 : 512) + ch; }
  if (r < 2816) return s0 + 1304 + 1024 + (r - 2304);
  if (r < 3328) return s0 + 1304 + 1536 + (r - 2816);
  if (r < 3352) return s0 + 1280 + (r - 3328);
  return nullptr;
}
__device__ void conv_tile(int type, const float* s0, const float* s1, int ldsrc, const float* gain, int K,
                          u16* dst, int r0, int k0, float* lds, bool valid) {
  const int tid = otid(), tx = tid & 63, ty = tid >> 6;
  const float* sp = valid ? conv_src(type, r0 + tx, s0, s1) : nullptr;
  float vals[32];
#pragma unroll
  for (int i = 0; i < 32; i++) {
    const int k = k0 + ty * 32 + i;
    vals[i] = sp ? sp[(size_t)k * ldsrc] : 0.f;
  }
#pragma unroll
  for (int i = 0; i < 32; i++) {
    const int k = k0 + ty * 32 + i;
    float v = vals[i];
    if (gain) v *= gain[k];
    lds[(ty * 32 + i) * 65 + tx] = v;
  }
  __syncthreads();
  const int rr = tid >> 2, ks = (tid & 3) * 32;
  unsigned w[16];
#pragma unroll
  for (int i = 0; i < 16; i++) w[i] = pk2(lds[(ks + 2 * i) * 65 + rr], lds[(ks + 2 * i + 1) * 65 + rr]);
  if (valid) {
    uint4* dp = (uint4*)(dst + (size_t)(r0 + rr) * K + k0 + ks);
    dp[0] = make_uint4(w[0], w[1], w[2], w[3]);
    dp[1] = make_uint4(w[4], w[5], w[6], w[7]);
    dp[2] = make_uint4(w[8], w[9], w[10], w[11]);
    dp[3] = make_uint4(w[12], w[13], w[14], w[15]);
  }
  __syncthreads();
}
__device__ void conv_matrix(int type, const float* s0, const float* s1, int ldsrc, const float* gain, int K, int NR,
                            u16* dst, float* lds, int& cursor) {
  const int tk = K / 128, tiles = (NR / 64) * tk, npairs = (tiles + 1) >> 1;
  const int G = (int)gridDim.x, half = ohalf();
  int first = ((int)blockIdx.x - (cursor % G) + G) % G;
  for (int pi = first; pi < npairs; pi += G) {
    const int t = 2 * pi + half;
    const bool valid = t < tiles;
    const int tt = valid ? t : 0;
    conv_tile(type, s0, s1, ldsrc, gain, K, dst, (tt / tk) * 64, (tt % tk) * 128, lds + half * 8448, valid);
  }
  cursor += npairs;
}

__device__ void phase_convert(const Params& p, int l, float* lds) {
  unsigned char* ws = p.ws;
  int cur = 0;
  const size_t oFF = (size_t)l * DM * DFF;
#pragma unroll 1
  for (int mi = 0; mi < 10; mi++) {
    int type = 0, ldsrc = DM, K = DM, NR = DM;
    const float *s0 = nullptr, *s1 = nullptr, *gain = nullptr;
    u16* dst = nullptr;
    switch (mi) {
      case 0: type = 1; s0 = p.ffn1_wg + oFF; s1 = p.ffn1_wu + oFF; ldsrc = DFF; gain = p.ffn1_norm + l * DM; K = DM; NR = 2 * DFF; dst = (u16*)(ws + OFF_WGU1); break;
      case 1: type = 0; s0 = p.ffn1_wd + oFF; ldsrc = DM; K = DFF; NR = DM; dst = (u16*)(ws + OFF_WD1); break;
      case 2: type = 2; s0 = p.w_in + (size_t)l * DM * 3352; ldsrc = 3352; gain = p.mix_norm + l * DM; K = DM; NR = NINP; dst = (u16*)(ws + OFF_WIN); break;
      case 3: type = 0; s0 = p.w_out + (size_t)l * DM * DM; ldsrc = DM; K = DM; NR = DM; dst = (u16*)(ws + OFF_WOUT); break;
      case 4: type = 1; s0 = p.ffn2_wg + oFF; s1 = p.ffn2_wu + oFF; ldsrc = DFF; gain = p.ffn2_norm + l * DM; K = DM; NR = 2 * DFF; dst = (u16*)(ws + OFF_WGU2); break;
      case 5: type = 0; s0 = p.ffn2_wd + oFF; ldsrc = DM; K = DFF; NR = DM; dst = (u16*)(ws + OFF_WD2); break;
      case 6: case 7: { const int kv = mi - 6; type = 0; s0 = p.cmp_w1 + (size_t)(l * 2 + kv) * 2048 * 128; ldsrc = 128; K = 2048; NR = 128; dst = (u16*)(ws + OFF_CW1T) + (size_t)kv * 128 * 2048; } break;
      default: { const int kv = mi - 8; type = 0; s0 = p.cmp_w2 + (size_t)(l * 2 + kv) * 128 * 64; ldsrc = 64; K = 128; NR = 64; dst = (u16*)(ws + OFF_CW2T) + (size_t)kv * 64 * 128; } break;
    }
    conv_matrix(type, s0, s1, ldsrc, gain, K, NR, dst, lds, cur);
  }
  if (blockIdx.x < 16 && ohalf() == 0) {
    const int kv = otid() >> 7, e = otid() & 127;
    const float* pos = p.cmp_pos + (size_t)(l * 2 + kv) * 2048 + blockIdx.x * 128;
    const float* w1 = p.cmp_w1 + ((size_t)(l * 2 + kv) * 2048 + blockIdx.x * 128) * 128;
    float sacc = 0.f;
#pragma unroll 64
    for (int i = 0; i < 128; i++) sacc += pos[i] * w1[(size_t)i * 128 + e];
    ((float*)(ws + OFF_CBP))[blockIdx.x * 256 + kv * 128 + e] = sacc;
  }
}

__device__ void phase_init(const Params& p) {
  unsigned char* ws = p.ws;
  const int tid = ofull(), lane = tid & 63, wid = tid >> 6;
  const int gw = blockIdx.x * 8 + wid, nw = gridDim.x * 8;
  float* rowss = (float*)(ws + OFF_ROWSS);
  u16* xb = (u16*)(ws + OFF_XB);
  for (int m = gw; m < MT; m += 2 * nw) {
    const int m2 = m + nw;
    const float4* xr = (const float4*)(p.x + (size_t)m * DM);
    const float4* xr2 = (const float4*)(p.x + (size_t)m2 * DM);
    float4 va[4], vb[4];
#pragma unroll
    for (int i = 0; i < 4; i++) { va[i] = xr[lane + 64 * i]; vb[i] = xr2[lane + 64 * i]; }
    float ss = 0.f, ss2 = 0.f;
#pragma unroll
    for (int i = 0; i < 4; i++) {
      const float4 v = va[i], w_ = vb[i];
      *(uint2*)(xb + (size_t)m * DM + (lane + 64 * i) * 4) = pk4(v.x, v.y, v.z, v.w);
      *(uint2*)(xb + (size_t)m2 * DM + (lane + 64 * i) * 4) = pk4(w_.x, w_.y, w_.z, w_.w);
      ss += v.x * v.x + v.y * v.y + v.z * v.z + v.w * v.w;
      ss2 += w_.x * w_.x + w_.y * w_.y + w_.z * w_.z + w_.w * w_.w;
    }
#pragma unroll
    for (int o = 32; o > 0; o >>= 1) { ss += __shfl_xor(ss, o); ss2 += __shfl_xor(ss2, o); }
    if (lane < 16) {
      rowss[(size_t)m * 16 + lane] = (lane == 0) ? ss : 0.f;
      rowss[(size_t)m2 * 16 + lane] = (lane == 0) ? ss2 : 0.f;
    }
  }
  const int gt = blockIdx.x * 512 + tid, nt = gridDim.x * 512;
  float* ct = (float*)(ws + OFF_COS);
  float* st = (float*)(ws + OFF_SIN);
  for (int i = gt; i < SL * 32; i += nt) {
    int t = i >> 5, d = i & 31;
    float inv = 1.0f / powf(10000.0f, (float)(2 * d) / 64.0f);
    float ang = (float)t * inv;
    ct[i] = cosf(ang);
    st[i] = sinf(ang);
  }
  float* lb = (float*)(ws + OFF_LB);
  for (int i = gt; i < 512; i += nt) {
    float z0 = p.lb_logits[i], z1 = p.lb_logits[512 + i];
    float mx = fmaxf(z0, z1);
    float e0 = expf(z0 - mx), e1 = expf(z1 - mx);
    lb[i] = 0.f;
    lb[512 + i] = e1 / (e0 + e1);
  }
}

template <int OFF> __device__ __forceinline__ bf16x8 ldsr128(unsigned addr) {
  bf16x8 v;
  asm volatile("ds_read_b128 %0, %1 offset:%2" : "=v"(v) : "v"(addr), "n"(OFF));
  return v;
}
__device__ __forceinline__ void lds_wait8(bf16x8& a0, bf16x8& a1, bf16x8& a2, bf16x8& a3, bf16x8& b0, bf16x8& b1, bf16x8& b2, bf16x8& b3) {
  asm volatile("s_waitcnt lgkmcnt(0)" : "+v"(a0), "+v"(a1), "+v"(a2), "+v"(a3), "+v"(b0), "+v"(b1), "+v"(b2), "+v"(b3));
}
template <int OFF> __device__ __forceinline__ uint2 ldsr64(unsigned addr) {
  uint2 v;
  asm volatile("ds_read_b64 %0, %1 offset:%2" : "=v"(v) : "v"(addr), "n"(OFF));
  return v;
}
constexpr int SM_GEMM = 131072;

template <bool BIG, bool M4>
__device__ __forceinline__ void gemm_main8(const u16* __restrict__ A, int lda, const u16* __restrict__ Bt, int ldb, int K,
                                           u16* sm, f32x4 (&acc)[2][4][4]) {
  constexpr int STG = BIG ? 65536 : 49152;
  const int tid = ofull(), lane = tid & 63, wid = tid >> 6;
  const int wr = BIG ? (wid >> 2) : (wid >> 1), wc = BIG ? (wid & 3) : (wid & 1);
  const int lr = lane & 15, quad = lane >> 4;
  const int ldrow = tid >> 3, lc = (tid & 7) ^ (ldrow & 7);
  const u16* ap = A + (size_t)ldrow * lda + lc * 8;
  const u16* bp = Bt + (size_t)ldrow * ldb + lc * 8;
  unsigned char* smb = (unsigned char*)sm;
#define GEMM_ISSUE(stage, k0)                                                                                         \
  do {                                                                                                                \
    _Pragma("unroll") for (int i_ = 0; i_ < 4; i_++)                                                                  \
      __builtin_amdgcn_global_load_lds((const unsigned*)(ap + (size_t)i_ * 64 * lda + (k0)),                          \
                                       (unsigned*)(smb + (stage) * STG + (tid + 512 * i_) * 16), 16, 0, 0);           \
    _Pragma("unroll") for (int i_ = 0; i_ < (BIG ? 4 : 2); i_++)                                                      \
      __builtin_amdgcn_global_load_lds((const unsigned*)(bp + (size_t)i_ * 64 * ldb + (k0)),                          \
                                       (unsigned*)(smb + (stage) * STG + 32768 + (tid + 512 * i_) * 16), 16, 0, 0);   \
  } while (0)
  const unsigned smbase = (unsigned)(size_t)smb;
  const int nk = K >> 6;
  GEMM_ISSUE(0, 0);
#pragma unroll
  for (int h = 0; h < 2; h++)
#pragma unroll
    for (int mf = 0; mf < 4; mf++)
#pragma unroll
      for (int nf = 0; nf < 4; nf++) acc[h][mf][nf] = f32x4{0.f, 0.f, 0.f, 0.f};
  const int sw0 = (quad ^ (lr & 7)) * 16, sw1 = sw0 ^ 64;
  const int arow = (wr * (BIG ? 128 : 64) + lr) * 128, brow = 32768 + (wc * 64 + lr) * 128;
#pragma unroll 1
  for (int kt = 0; kt < nk; kt++) {
    asm volatile("s_waitcnt vmcnt(0)" ::: "memory");
    __builtin_amdgcn_s_barrier();
    __builtin_amdgcn_sched_barrier(0);
    const unsigned sb_ = smbase + (kt & 1) * STG;
    if (BIG) {
      const unsigned ca0 = sb_ + arow + sw0, cb0 = sb_ + brow + sw0, ca1 = sb_ + arow + sw1, cb1 = sb_ + brow + sw1;
      bf16x8 b0[4], b1[4], af[4], ag[4];
      b0[0] = ldsr128<0>(cb0); b0[1] = ldsr128<2048>(cb0); b0[2] = ldsr128<4096>(cb0); b0[3] = ldsr128<6144>(cb0);
      af[0] = ldsr128<0>(ca0); af[1] = ldsr128<2048>(ca0); af[2] = ldsr128<4096>(ca0); af[3] = ldsr128<6144>(ca0);
      if (kt + 1 < nk) GEMM_ISSUE((kt + 1) & 1, (kt + 1) * 64);
      asm volatile("s_waitcnt lgkmcnt(0)" : "+v"(af[0]), "+v"(af[1]), "+v"(af[2]), "+v"(af[3]), "+v"(b0[0]), "+v"(b0[1]), "+v"(b0[2]), "+v"(b0[3]));
      ag[0] = ldsr128<8192>(ca0); ag[1] = ldsr128<10240>(ca0); ag[2] = ldsr128<12288>(ca0); ag[3] = ldsr128<14336>(ca0);
      __builtin_amdgcn_s_setprio(1);
#pragma unroll
      for (int mf = 0; mf < 4; mf++)
#pragma unroll
        for (int nf = 0; nf < 4; nf++) acc[0][mf][nf] = M4 ? mfma16(af[mf], b0[nf], acc[0][mf][nf]) : mfma16(b0[nf], af[mf], acc[0][mf][nf]);
      __builtin_amdgcn_s_setprio(0);
      asm volatile("s_waitcnt lgkmcnt(0)" : "+v"(ag[0]), "+v"(ag[1]), "+v"(ag[2]), "+v"(ag[3]));
      b1[0] = ldsr128<0>(cb1); b1[1] = ldsr128<2048>(cb1); b1[2] = ldsr128<4096>(cb1); b1[3] = ldsr128<6144>(cb1);
      af[0] = ldsr128<0>(ca1); af[1] = ldsr128<2048>(ca1); af[2] = ldsr128<4096>(ca1); af[3] = ldsr128<6144>(ca1);
      __builtin_amdgcn_s_setprio(1);
#pragma unroll
      for (int mf = 0; mf < 4; mf++)
#pragma unroll
        for (int nf = 0; nf < 4; nf++) acc[1][mf][nf] = M4 ? mfma16(ag[mf], b0[nf], acc[1][mf][nf]) : mfma16(b0[nf], ag[mf], acc[1][mf][nf]);
      __builtin_amdgcn_s_setprio(0);
      asm volatile("s_waitcnt lgkmcnt(0)" : "+v"(af[0]), "+v"(af[1]), "+v"(af[2]), "+v"(af[3]), "+v"(b1[0]), "+v"(b1[1]), "+v"(b1[2]), "+v"(b1[3]));
      ag[0] = ldsr128<8192>(ca1); ag[1] = ldsr128<10240>(ca1); ag[2] = ldsr128<12288>(ca1); ag[3] = ldsr128<14336>(ca1);
      __builtin_amdgcn_s_setprio(1);
#pragma unroll
      for (int mf = 0; mf < 4; mf++)
#pragma unroll
        for (int nf = 0; nf < 4; nf++) acc[0][mf][nf] = M4 ? mfma16(af[mf], b1[nf], acc[0][mf][nf]) : mfma16(b1[nf], af[mf], acc[0][mf][nf]);
      __builtin_amdgcn_s_setprio(0);
      asm volatile("s_waitcnt lgkmcnt(0)" : "+v"(ag[0]), "+v"(ag[1]), "+v"(ag[2]), "+v"(ag[3]));
      __builtin_amdgcn_s_setprio(1);
#pragma unroll
      for (int mf = 0; mf < 4; mf++)
#pragma unroll
        for (int nf = 0; nf < 4; nf++) acc[1][mf][nf] = M4 ? mfma16(ag[mf], b1[nf], acc[1][mf][nf]) : mfma16(b1[nf], ag[mf], acc[1][mf][nf]);
      __builtin_amdgcn_s_setprio(0);
    } else {
      const unsigned ca0 = sb_ + arow + sw0, cb0 = sb_ + brow + sw0, ca1 = sb_ + arow + sw1, cb1 = sb_ + brow + sw1;
      bf16x8 b0[4], a0[4], b1[4], a1[4];
      b0[0] = ldsr128<0>(cb0); b0[1] = ldsr128<2048>(cb0); b0[2] = ldsr128<4096>(cb0); b0[3] = ldsr128<6144>(cb0);
      a0[0] = ldsr128<0>(ca0); a0[1] = ldsr128<2048>(ca0); a0[2] = ldsr128<4096>(ca0); a0[3] = ldsr128<6144>(ca0);
      if (kt + 1 < nk) GEMM_ISSUE((kt + 1) & 1, (kt + 1) * 64);
      asm volatile("s_waitcnt lgkmcnt(0)" : "+v"(a0[0]), "+v"(a0[1]), "+v"(a0[2]), "+v"(a0[3]), "+v"(b0[0]), "+v"(b0[1]), "+v"(b0[2]), "+v"(b0[3]));
      b1[0] = ldsr128<0>(cb1); b1[1] = ldsr128<2048>(cb1); b1[2] = ldsr128<4096>(cb1); b1[3] = ldsr128<6144>(cb1);
      a1[0] = ldsr128<0>(ca1); a1[1] = ldsr128<2048>(ca1); a1[2] = ldsr128<4096>(ca1); a1[3] = ldsr128<6144>(ca1);
#pragma unroll
      for (int mf = 0; mf < 4; mf++)
#pragma unroll
        for (int nf = 0; nf < 4; nf++) {
          if (M4) acc[0][mf][nf] = mfma16(a0[mf], b0[nf], acc[0][mf][nf]);
          else    acc[0][mf][nf] = mfma16(b0[nf], a0[mf], acc[0][mf][nf]);
        }
      asm volatile("s_waitcnt lgkmcnt(0)" : "+v"(a1[0]), "+v"(a1[1]), "+v"(a1[2]), "+v"(a1[3]), "+v"(b1[0]), "+v"(b1[1]), "+v"(b1[2]), "+v"(b1[3]));
#pragma unroll
      for (int mf = 0; mf < 4; mf++)
#pragma unroll
        for (int nf = 0; nf < 4; nf++) {
          if (M4) acc[0][mf][nf] = mfma16(a1[mf], b1[nf], acc[0][mf][nf]);
          else    acc[0][mf][nf] = mfma16(b1[nf], a1[mf], acc[0][mf][nf]);
        }
    }
  }
  __syncthreads();
#undef GEMM_ISSUE
}

__device__ __forceinline__ bool tile_of(int u_iter, int NT, int& mt, int& nt) {
  const int nx = 8;
  const int per = gridDim.x / nx;
  const int xcd = blockIdx.x % nx, local = blockIdx.x / nx;
  if ((int)blockIdx.x >= per * nx) return false;
  const int u = local + u_iter * per;
  if (u >= 8 * NT) return false;
  mt = xcd * 8 + (u & 7);
  nt = u >> 3;
  return true;
}

__device__ __forceinline__ void epi_swiglu(f32x4 (&acc)[4][4], int mb, int nb, const float* rsl, u16* H) {
  const int lane = otid() & 63, lr = lane & 15, quad = lane >> 4;
#pragma unroll
  for (int mf = 0; mf < 4; mf++) {
    const int m = mb + mf * 16 + lr;
    const float rs = rsl[mf * 16 + lr];
#pragma unroll
    for (int pp = 0; pp < 2; pp++) {
      float h[4];
#pragma unroll
      for (int j = 0; j < 4; j++) {
        float g = acc[mf][2 * pp][j] * rs, u = acc[mf][2 * pp + 1][j] * rs;
        h[j] = siluf_(g) * u;
      }
      const int hid = (nb >> 1) + pp * 16 + quad * 4;
      *(uint2*)(H + (size_t)m * DFF + hid) = pk4(h[0], h[1], h[2], h[3]);
    }
  }
}
__device__ __forceinline__ void epi_resid(f32x4 (&acc)[4][4], int mb, int nb, float scale, float* x, u16* xb, float* rowss_next) {
  const int lane = otid() & 63, lr = lane & 15, quad = lane >> 4;
#pragma unroll
  for (int mf = 0; mf < 4; mf++) {
    const int m = mb + mf * 16 + lr;
    float ss = 0.f;
#pragma unroll
    for (int nf = 0; nf < 4; nf++) {
      const int n = nb + nf * 16 + quad * 4;
      float4* xp = (float4*)(x + (size_t)m * DM + n);
      float4 xv = *xp;
      xv.x += scale * acc[mf][nf][0]; xv.y += scale * acc[mf][nf][1];
      xv.z += scale * acc[mf][nf][2]; xv.w += scale * acc[mf][nf][3];
      *xp = xv;
      *(uint2*)(xb + (size_t)m * DM + n) = pk4(xv.x, xv.y, xv.z, xv.w);
      ss += xv.x * xv.x + xv.y * xv.y + xv.z * xv.z + xv.w * xv.w;
    }
    ss += __shfl_xor(ss, 16);
    ss += __shfl_xor(ss, 32);
    if (quad == 0) rowss_next[(size_t)m * 16 + (nb >> 6)] = ss;
  }
}

__device__ __forceinline__ void epi_swiglu_lds(f32x4 (&acc)[4][4], int mb, int nb, const float* rsl, u16* H, float* T) {
  const int lane = otid() & 63, lr = lane & 15, quad = lane >> 4;
#pragma unroll
  for (int mf = 0; mf < 4; mf++)
#pragma unroll
    for (int nf = 0; nf < 4; nf++)
      *(f32x4*)(T + (mf * 16 + lr) * 64 + (((nf * 4 + quad) ^ lr) * 4)) = acc[mf][nf];
  const int l8 = lane & 7, gch = (l8 < 4) ? l8 : l8 + 4, uch = gch + 4;
#pragma unroll
  for (int i = 0; i < 8; i++) {
    const int r = (lane >> 3) + 8 * i;
    const f32x4 g4 = *(const f32x4*)(T + r * 64 + ((gch ^ (r & 15)) * 4));
    const f32x4 u4 = *(const f32x4*)(T + r * 64 + ((uch ^ (r & 15)) * 4));
    const float rs = rsl[r];
    float h[4];
#pragma unroll
    for (int j = 0; j < 4; j++) h[j] = siluf_(g4[j] * rs) * (u4[j] * rs);
    *(uint2*)(H + (size_t)(mb + r) * DFF + (nb >> 1) + l8 * 4) = pk4(h[0], h[1], h[2], h[3]);
  }
}

__device__ __forceinline__ void epi_resid_lds(f32x4 (&acc)[4][4], int mb, int nb, float scale, float* xout, u16* xb, float* rowss_next, float* T) {
  const int lane = otid() & 63, lr = lane & 15, quad = lane >> 4;
#pragma unroll
  for (int mf = 0; mf < 4; mf++)
#pragma unroll
    for (int nf = 0; nf < 4; nf++)
      *(f32x4*)(T + (mf * 16 + lr) * 64 + (((nf * 4 + quad) ^ lr) * 4)) = acc[mf][nf];
  uint2 xin[16];
#pragma unroll
  for (int i = 0; i < 16; i++) xin[i] = *(const uint2*)(xb + (size_t)(mb + quad + 4 * i) * DM + nb + lr * 4);
#pragma unroll
  for (int i = 0; i < 16; i++) {
    const int r = quad + 4 * i, c4 = lr;
    const f32x4 a = *(const f32x4*)(T + r * 64 + ((c4 ^ (r & 15)) * 4));
    const int m = mb + r, n = nb + c4 * 4;
    float4 xv;
    xv.x = bf2f((u16)(xin[i].x & 0xffff)) + scale * a[0];
    xv.y = bf2f((u16)(xin[i].x >> 16)) + scale * a[1];
    xv.z = bf2f((u16)(xin[i].y & 0xffff)) + scale * a[2];
    xv.w = bf2f((u16)(xin[i].y >> 16)) + scale * a[3];
    if (xout) {
      *(float4*)(xout + (size_t)m * DM + n) = xv;
    } else {
      *(uint2*)(xb + (size_t)m * DM + n) = pk4(xv.x, xv.y, xv.z, xv.w);
      float ss = xv.x * xv.x + xv.y * xv.y + xv.z * xv.z + xv.w * xv.w;
      ss += __shfl_xor(ss, 1);
      ss += __shfl_xor(ss, 2);
      ss += __shfl_xor(ss, 4);
      ss += __shfl_xor(ss, 8);
      if (c4 == 0) rowss_next[(size_t)m * 16 + (nb >> 6)] = ss;
    }
  }
}

__device__ __forceinline__ void epi_inproj_n4(const Params& p, int l, f32x4 (&acc)[4][4], int mb, int nt, int wc, const float* rsl) {
  unsigned char* ws = p.ws;
  const int lane = otid() & 63, lr = lane & 15, quad = lane >> 4;
  const float* ct = (const float*)(ws + OFF_COS);
  const float* st = (const float*)(ws + OFF_SIN);
#pragma unroll
  for (int mf = 0; mf < 4; mf++) {
    const int m = mb + mf * 16 + lr;
    const int b = m >> 12, t = m & 4095;
    const float rs = rsl[mf * 16 + lr];
    float v[4][4];
#pragma unroll
    for (int nf = 0; nf < 4; nf++)
#pragma unroll
      for (int j = 0; j < 4; j++) v[nf][j] = acc[mf][nf][j] * rs;
    if (nt == 26) {
      if (wc == 0) {
        float* gp = (float*)(ws + OFF_GATES) + (size_t)m * 24;
#pragma unroll
        for (int nf = 0; nf < 2; nf++)
#pragma unroll
          for (int j = 0; j < 4; j++) { int c = nf * 16 + quad * 4 + j; if (c < 24) gp[c] = sigmoidf_(v[nf][j]); }
      }
    } else if (nt >= 22) {
      u16* dp = (u16*)(ws + OFF_HG) + (size_t)m * 512 + (nt - 22) * 128 + wc * 64 + quad * 4;
#pragma unroll
      for (int nf = 0; nf < 4; nf++) *(uint2*)(dp + nf * 16) = pk4(v[nf][0], v[nf][1], v[nf][2], v[nf][3]);
    } else if (nt == 5) {
      u16* dp = (u16*)(ws + OFF_VC) + ((size_t)((b * 2 + wc) * SL + t)) * 64 + quad * 4;
#pragma unroll
      for (int nf = 0; nf < 4; nf++) *(uint2*)(dp + nf * 16) = pk4(v[nf][0], v[nf][1], v[nf][2], v[nf][3]);
    } else {
      const float* gain;
      u16* dp;
      if (nt < 4) { gain = p.q_norm + l * 64; dp = (u16*)(ws + OFF_Q) + (size_t)m * 512 + (nt * 2 + wc) * 64; }
      else {
        const int ki = (nt - 4) >> 1;
        gain = p.k_norm + (l * 3 + ki) * 64;
        const size_t off = (nt == 4) ? OFF_KC : (nt == 6 ? OFF_KS : OFF_KW);
        dp = (u16*)(ws + off) + ((size_t)((b * 2 + wc) * SL + t)) * 64;
      }
      float ss = 0.f;
#pragma unroll
      for (int nf = 0; nf < 4; nf++)
#pragma unroll
        for (int j = 0; j < 4; j++) ss += v[nf][j] * v[nf][j];
      ss += __shfl_xor(ss, 16);
      ss += __shfl_xor(ss, 32);
      float r = rsqrtf(ss * (1.f / 64.f) + EPSV);
      if (nt < 4) r *= SCL2;
#pragma unroll
      for (int nf = 0; nf < 4; nf++) {
        const float4 g4 = *(const float4*)(gain + nf * 16 + quad * 4);
        v[nf][0] *= r * g4.x; v[nf][1] *= r * g4.y; v[nf][2] *= r * g4.z; v[nf][3] *= r * g4.w;
      }
#pragma unroll
      for (int nf = 0; nf < 2; nf++) {
        const float4 c4 = *(const float4*)(ct + t * 32 + nf * 16 + quad * 4);
        const float4 s4 = *(const float4*)(st + t * 32 + nf * 16 + quad * 4);
        const float cc[4] = {c4.x, c4.y, c4.z, c4.w}, sn[4] = {s4.x, s4.y, s4.z, s4.w};
        float lo[4], hi[4];
#pragma unroll
        for (int j = 0; j < 4; j++) {
          lo[j] = v[nf][j] * cc[j] - v[nf + 2][j] * sn[j];
          hi[j] = v[nf + 2][j] * cc[j] + v[nf][j] * sn[j];
        }
        *(uint2*)(dp + nf * 16 + quad * 4) = pk4(lo[0], lo[1], lo[2], lo[3]);
        *(uint2*)(dp + (nf + 2) * 16 + quad * 4) = pk4(hi[0], hi[1], hi[2], hi[3]);
      }
    }
    __builtin_amdgcn_sched_barrier(0);
  }
}

__device__ __forceinline__ void epi_inproj_m4(const Params& p, int l, f32x4 (&acc)[4][4], int mb, int nt, int wc, const float* rsl) {
  unsigned char* ws = p.ws;
  const int lane = otid() & 63, lr = lane & 15, quad = lane >> 4;
  float rs[4][4];
#pragma unroll
  for (int mf = 0; mf < 4; mf++) {
    const float4 r4 = *(const float4*)(rsl + mf * 16 + quad * 4);
    rs[mf][0] = r4.x; rs[mf][1] = r4.y; rs[mf][2] = r4.z; rs[mf][3] = r4.w;
  }
  if (nt == 7 || nt == 9) {
    u16* base = (u16*)(ws + (nt == 7 ? OFF_VST : OFF_VWT));
#pragma unroll
    for (int mf = 0; mf < 4; mf++) {
      const int m0 = mb + mf * 16 + quad * 4;
      const int b = m0 >> 12, t0 = m0 & 4095;
#pragma unroll
      for (int nf = 0; nf < 4; nf++) {
        const int d = nf * 16 + lr;
        *(uint2*)(base + ((size_t)((b * 2 + wc) * 64 + d)) * SL + t0) =
            pk4(acc[mf][nf][0] * rs[mf][0], acc[mf][nf][1] * rs[mf][1], acc[mf][nf][2] * rs[mf][2], acc[mf][nf][3] * rs[mf][3]);
      }
    }
  } else if (nt >= 18) {
    u16* base = (u16*)(ws + OFF_VHT);
#pragma unroll
    for (int mf = 0; mf < 4; mf++) {
      const int m0 = mb + mf * 16 + quad * 4;
#pragma unroll
      for (int nf = 0; nf < 4; nf++) {
        const int ch = (nt - 18) * 128 + wc * 64 + nf * 16 + lr;
        *(uint2*)(base + (size_t)ch * MT + m0) =
            pk4(acc[mf][nf][0] * rs[mf][0], acc[mf][nf][1] * rs[mf][1], acc[mf][nf][2] * rs[mf][2], acc[mf][nf][3] * rs[mf][3]);
      }
    }
  } else {
    const float* lbp = (const float*)(ws + OFF_LB) + l * 512;
    u16* qtT = (u16*)(ws + OFF_QTT);
    u16* ktT = (u16*)(ws + OFF_KTT);
    const int chunk = mb >> 6;
#pragma unroll
    for (int pp = 0; pp < 2; pp++) {
      const int ch = (nt - 10) * 64 + wc * 32 + pp * 16 + lr;
      const float lbv = lbp[ch];
      float bv[4][4], kk[4][4];
      float run = 0.f;
#pragma unroll
      for (int mf = 0; mf < 4; mf++) {
        float lf[4];
#pragma unroll
        for (int j = 0; j < 4; j++) {
          const float xf = acc[mf][2 * pp + 1][j] * rs[mf][j];
          const float sg = __builtin_amdgcn_rcpf(1.f + __expf(-xf));
          const float nsg = __builtin_amdgcn_rcpf(1.f + __expf(xf));
          const float f = lbv + (1.f - lbv) * sg;
          lf[j] = __logf(fmaxf(f, 1e-30f));
          kk[mf][j] = (1.f - lbv) * nsg;
        }
        const float c0 = lf[0], c1 = c0 + lf[1], c2 = c1 + lf[2], c3 = c2 + lf[3];
        const float t0 = __shfl(c3, lr), t1 = __shfl(c3, lr + 16), t2 = __shfl(c3, lr + 32), t3 = __shfl(c3, lr + 48);
        const float pre = (quad > 0 ? t0 : 0.f) + (quad > 1 ? t1 : 0.f) + (quad > 2 ? t2 : 0.f);
        const float base = run + pre;
        bv[mf][0] = base + c0; bv[mf][1] = base + c1; bv[mf][2] = base + c2; bv[mf][3] = base + c3;
        run += t0 + t1 + t2 + t3;
      }
      const float bm = __shfl(bv[1][3], lr + 48);
      const float bl = __shfl(bv[3][3], lr + 48);
#pragma unroll
      for (int mf = 0; mf < 4; mf++) {
        const int m0 = mb + mf * 16 + quad * 4;
        float qv[4], kv[4];
#pragma unroll
        for (int j = 0; j < 4; j++) {
          const float xq = acc[mf][2 * pp][j] * rs[mf][j];
          qv[j] = siluf_(xq) * __expf(bv[mf][j] - bm);
          kv[j] = kk[mf][j] * __expf(bm - bv[mf][j]);
        }
        *(uint2*)(qtT + (size_t)ch * MT + m0) = pk4(qv[0], qv[1], qv[2], qv[3]);
        *(uint2*)(ktT + (size_t)ch * MT + m0) = pk4(kv[0], kv[1], kv[2], kv[3]);
      }
      if (quad == 0) {
        ((float*)(ws + OFF_CVEM))[chunk * 512 + ch] = __expf(bm);
        ((float*)(ws + OFF_CVDL))[chunk * 512 + ch] = __expf(bl);
        ((float*)(ws + OFF_CVE1))[chunk * 512 + ch] = __expf(bl - bm);
      }
    }
  }
}

enum { G_UP = 0, G_DOWN = 1, G_INPROJ = 2 };

__device__ __forceinline__ void phase_gemm(const Params& p, int l, int kind, const u16* A, int lda, const u16* Bt, int ldb, int K, int NT,
                           const float* rowss_in, float* rowss_out, float scale, u16* Hout, u16* sm, bool fin = false) {
  const int ftid = ofull(), wid = ftid >> 6;
  float* rsl_all = (float*)((unsigned char*)sm + SM_GEMM);
  f32x4 acc[2][4][4];
  const int per_ = gridDim.x / 8, full_ = (8 * NT) / per_, rem_ = 8 * NT - full_ * per_;
  const bool split_tail = (kind == G_UP || kind == G_INPROJ) && (rem_ * 2 == per_);
  float* Tw = (float*)((unsigned char*)sm + wid * 16384);
  for (int it = 0;; it++) {
    int mt, nt;
    if (split_tail && it == full_) {
      const int local = blockIdx.x / 8, xcd = blockIdx.x % 8;
      const int u = full_ * per_ + (local >> 1), nh = local & 1;
      mt = xcd * 8 + (u & 7); nt = u >> 3;
      const int m0 = mt * 256;
      __syncthreads();
      if (ftid < 256) {
        const float4* rp = (const float4*)(rowss_in + (size_t)(m0 + ftid) * 16);
        const float4 a0 = rp[0], a1 = rp[1], a2 = rp[2], a3 = rp[3];
        float sm_ = ((a0.x + a0.y) + (a0.z + a0.w)) + ((a1.x + a1.y) + (a1.z + a1.w)) + ((a2.x + a2.y) + (a2.z + a2.w)) + ((a3.x + a3.y) + (a3.z + a3.w));
        rsl_all[ftid] = rsqrtf(sm_ * (1.f / 1024.f) + EPSV);
      }
      const int wr = wid >> 1, wc = wid & 1;
      const int n0 = nt * 256 + nh * 128;
      if (kind == G_UP) {
        gemm_main8<false, false>(A + (size_t)m0 * lda, lda, Bt + (size_t)n0 * ldb, ldb, K, sm, acc);
        epi_swiglu(acc[0], m0 + wr * 64, n0 + wc * 64, rsl_all + wr * 64, Hout);
      } else {
        const int nt128 = n0 >> 7;
        const bool m4 = (nt128 == 7 || nt128 == 9 || (nt128 >= 10 && nt128 < 22));
        if (m4) gemm_main8<false, true>(A + (size_t)m0 * lda, lda, Bt + (size_t)n0 * ldb, ldb, K, sm, acc);
        else    gemm_main8<false, false>(A + (size_t)m0 * lda, lda, Bt + (size_t)n0 * ldb, ldb, K, sm, acc);
        if (nt128 < 27) {
          if (m4) epi_inproj_m4(p, l, acc[0], m0 + wr * 64, nt128, wc, rsl_all + wr * 64);
          else    epi_inproj_n4(p, l, acc[0], m0 + wr * 64, nt128, wc, rsl_all + wr * 64);
        }
      }
      break;
    }
    if (!tile_of(it, NT, mt, nt)) break;
    const int m0 = mt * 256;
    const u16* Ap = A + (size_t)m0 * lda;
    if (kind != G_DOWN) {
      __syncthreads();
      if (ftid < 256) {
        const float4* rp = (const float4*)(rowss_in + (size_t)(m0 + ftid) * 16);
        const float4 a0 = rp[0], a1 = rp[1], a2 = rp[2], a3 = rp[3];
        float sm_ = ((a0.x + a0.y) + (a0.z + a0.w)) + ((a1.x + a1.y) + (a1.z + a1.w)) + ((a2.x + a2.y) + (a2.z + a2.w)) + ((a3.x + a3.y) + (a3.z + a3.w));
        rsl_all[ftid] = rsqrtf(sm_ * (1.f / 1024.f) + EPSV);
      }
    }
    if (kind == G_INPROJ) {
      const int wr = wid >> 2, wc = wid & 3;
      const int n0 = nt * 256;
      const int g64 = nt * 4 + wc, nt128 = g64 >> 1, wc64 = g64 & 1;
      const u16* Bp = Bt + (size_t)n0 * ldb;
      const bool m4 = (nt128 == 7 || nt128 == 9 || (nt128 >= 10 && nt128 < 22));
      if (m4) gemm_main8<true, true>(Ap, lda, Bp, ldb, K, sm, acc);
      else    gemm_main8<true, false>(Ap, lda, Bp, ldb, K, sm, acc);
      {
        const int lane_ = ftid & 63;
#pragma unroll
        for (int mf = 0; mf < 4; mf++)
#pragma unroll
          for (int nf = 0; nf < 4; nf++) *(f32x4*)(Tw + ((mf * 4 + nf) * 64 + lane_) * 4) = acc[1][mf][nf];
      }
#pragma unroll 1
      for (int h = 0; h < 2; h++) {
        if (h == 1) {
          const int lane_ = ftid & 63;
#pragma unroll
          for (int mf = 0; mf < 4; mf++)
#pragma unroll
            for (int nf = 0; nf < 4; nf++) acc[0][mf][nf] = *(const f32x4*)(Tw + ((mf * 4 + nf) * 64 + lane_) * 4);
        }
        if (nt128 < 27) {
          if (m4) epi_inproj_m4(p, l, acc[0], m0 + wr * 128 + h * 64, nt128, wc64, rsl_all + wr * 128 + h * 64);
          else    epi_inproj_n4(p, l, acc[0], m0 + wr * 128 + h * 64, nt128, wc64, rsl_all + wr * 128 + h * 64);
        }
      }
    } else {
      const int wr = wid >> 2, wc = wid & 3;
      const int n0 = nt * 256, nb = n0 + wc * 64;
      const u16* Bp = Bt + (size_t)n0 * ldb;
      gemm_main8<true, false>(Ap, lda, Bp, ldb, K, sm, acc);
#pragma unroll
      for (int h = 0; h < 2; h++) {
        const int mb = m0 + wr * 128 + h * 64;
        const float* rsl = rsl_all + wr * 128 + h * 64;
        if (kind == G_UP) epi_swiglu(acc[h], mb, nb, rsl, Hout);
        else epi_resid_lds(acc[h], mb, nb, scale, fin ? p.out : nullptr, (u16*)(p.ws + OFF_XB), rowss_out, Tw);
      }
      if (kind == G_DOWN) __syncthreads();
    }
  }
}

__device__ __forceinline__ float gelu_tanh(float x) {
  const float u = 0.7978845608028654f * (x + 0.044715f * x * x * x);
  const float e = __expf(2.f * u);
  const float th = 1.f - 2.f * __builtin_amdgcn_rcpf(e + 1.f);
  return 0.5f * x * (1.f + th);
}
__device__ void compress_item(const Params& p, int item, u16* hs) {
  unsigned char* ws = p.ws;
  const int tid_ = otid(); const int lane = tid_ & 63, w = tid_ >> 6, lr = lane & 15, quad = lane >> 4;
  const int kv = item & 1, bg = (item >> 1) & 7, ng = item >> 4, n0 = ng * 16;
  const u16* src = (const u16*)(ws + (kv ? OFF_VC : OFF_KC));
  const u16* w1T = (const u16*)(ws + OFF_CW1T) + (size_t)kv * 128 * 2048;
  const u16* w2T = (const u16*)(ws + OFF_CW2T) + (size_t)kv * 64 * 128;
  const float* bias = (const float*)(ws + OFF_CBP) + kv * 128;
  const int n = n0 + lr, nc = n < 254 ? n : 254;
  const u16* ap = src + ((size_t)bg * SL + nc * 16) * 64 + quad * 8;
  const u16* bp = w1T + (size_t)(w * 32 + lr) * 2048 + quad * 8;
  f32x4 a0 = {0, 0, 0, 0}, a1 = {0, 0, 0, 0};
#pragma unroll 8
  for (int k = 0; k < 64; k++) {
    bf16x8 a = *(const bf16x8*)(ap + k * 32);
    bf16x8 b0 = *(const bf16x8*)(bp + k * 32);
    bf16x8 b1 = *(const bf16x8*)(bp + 16 * 2048 + k * 32);
    a0 = mfma16(a, b0, a0);
    a1 = mfma16(a, b1, a1);
  }
  {
    const int e0 = w * 32 + lr, e1 = w * 32 + 16 + lr;
    float be0 = 0.f, be1 = 0.f;
#pragma unroll 8
    for (int bb = 0; bb < 16; bb++) { be0 += bias[bb * 256 + e0]; be1 += bias[bb * 256 + e1]; }
#pragma unroll
    for (int j = 0; j < 4; j++) {
      hs[(quad * 4 + j) * 136 + e0] = f2bf(gelu_tanh(a0[j] + be0));
      hs[(quad * 4 + j) * 136 + e1] = f2bf(gelu_tanh(a1[j] + be1));
    }
  }
  __syncthreads();
  f32x4 o = {0, 0, 0, 0};
#pragma unroll
  for (int ks = 0; ks < 4; ks++) {
    bf16x8 a = *(const bf16x8*)(hs + lr * 136 + ks * 32 + quad * 8);
    bf16x8 b = *(const bf16x8*)(w2T + (size_t)(w * 16 + lr) * 128 + ks * 32 + quad * 8);
    o = mfma16(a, b, o);
  }
  if (kv == 0) {
    u16* kcc = (u16*)(ws + OFF_KCC);
#pragma unroll
    for (int j = 0; j < 4; j++) {
      int nn = n0 + quad * 4 + j;
      kcc[((size_t)bg * 256 + nn) * 64 + w * 16 + lr] = f2bf(nn <= 254 ? o[j] : 0.f);
    }
  } else {
    u16* vccT = (u16*)(ws + OFF_VCCT);
    int nn = n0 + quad * 4;
    float o3 = (nn + 3 <= 254) ? o[3] : 0.f;
    *(uint2*)(vccT + ((size_t)bg * 64 + w * 16 + lr) * 256 + nn) = pk4(o[0], o[1], o[2], o3);
  }
  __syncthreads();
}

__device__ void cmpattn_stage(const Params& p, int bg, unsigned char* lds) {
  unsigned char* ws = p.ws;
  const int tid = otid();
  const u16* kcc = (const u16*)(ws + OFF_KCC) + (size_t)bg * 256 * 64;
  const u16* vT = (const u16*)(ws + OFF_VCCT) + (size_t)bg * 64 * 256;
#pragma unroll
  for (int i = 0; i < 8; i++) {
    const int c = tid + 256 * i, row = c >> 3, lc = (c & 7) ^ ((row >> 1) & 7);
    __builtin_amdgcn_global_load_lds((const unsigned*)(kcc + (size_t)row * 64 + lc * 8), (unsigned*)(lds + c * 16), 16, 0, 0);
  }
#pragma unroll
  for (int i = 0; i < 8; i++) {
    const int c = tid + 256 * i, row = c >> 5, lc = (c & 31) ^ (row & 15);
    __builtin_amdgcn_global_load_lds((const unsigned*)(vT + (size_t)row * 256 + lc * 8), (unsigned*)(lds + 32768 + c * 16), 16, 0, 0);
  }
  asm volatile("s_waitcnt vmcnt(0)" ::: "memory");
  __syncthreads();
}

__device__ void cmpattn_item(const Params& p, int bg, int tt, const unsigned char* lds, float* imp) {
  unsigned char* ws = p.ws;
  const int tid_ = otid(); const int lane = tid_ & 63, w = tid_ >> 6, lr = lane & 15, quad = lane >> 4;
  const int t0 = tt * 16;
  const int b = bg >> 1, g = bg & 1;
  const int t = t0 + 4 * w + (lr >> 2);
  const int head = g * 4 + (lr & 3);
  const u16* qp = (const u16*)(ws + OFF_Q) + ((size_t)(b * SL + t)) * 512 + head * 64 + quad * 8;
  const bf16x8 q0 = *(const bf16x8*)qp, q1 = *(const bf16x8*)(qp + 32);
  const int tmax = t0 + 4 * w + 3;
  const int nvm = tmax >= 31 ? ((tmax - 31) >> 4) + 1 : 0;
  const int nfrag = (nvm + 15) >> 4;
  const int ksw = (lr >> 1) & 7;
  const float mx = 0.f;
  f32x4 O[4];
#pragma unroll
  for (int df = 0; df < 4; df++) O[df] = f32x4{0.f, 0.f, 0.f, 0.f};
  float sum = 0.f, prev_sh = 0.f;
  const int ngp = (nfrag + 1) >> 1;
#pragma unroll 2
  for (int gp = 0; gp < 8; gp++) {
    float pr[2][4];
    if (gp < ngp) {
#pragma unroll
      for (int hf = 0; hf < 2; hf++) {
        const int f = 2 * gp + hf;
        const unsigned char* kp = lds + (f * 16 + lr) * 128;
        f32x4 sv = mfma16(*(const bf16x8*)(kp + ((quad ^ ksw) * 16)), q0, f32x4{0.f, 0.f, 0.f, 0.f});
        sv = mfma16(*(const bf16x8*)(kp + (((4 + quad) ^ ksw) * 16)), q1, sv);
#pragma unroll
        for (int j = 0; j < 4; j++) {
          const int n = f * 16 + quad * 4 + j;
          const float pv = (16 * n + 31 <= t) ? ex2(sv[j] - mx) : 0.f;
          pr[hf][j] = pv;
          sum += pv;
        }
      }
      const bf16x8 pf = mk8(pk4(pr[0][0], pr[0][1], pr[0][2], pr[0][3]), pk4(pr[1][0], pr[1][1], pr[1][2], pr[1][3]));
#pragma unroll
      for (int df = 0; df < 4; df++) {
        const unsigned char* vp = lds + 32768 + (df * 16 + lr) * 512 + (quad & 1) * 8;
        const bf16x8 vf = mk8(*(const uint2*)(vp + (((gp * 4 + (quad >> 1)) ^ lr) * 16)), *(const uint2*)(vp + (((gp * 4 + 2 + (quad >> 1)) ^ lr) * 16)));
        O[df] = mfma16(vf, pf, O[df]);
      }
    } else {
#pragma unroll
      for (int hf = 0; hf < 2; hf++)
#pragma unroll
        for (int j = 0; j < 4; j++) pr[hf][j] = 0.f;
    }
#pragma unroll
    for (int hf = 0; hf < 2; hf++) {
      const int f = 2 * gp + hf;
      const float sh = __shfl(pr[hf][3], (lane - 16) & 63);
      const float add = (quad == 0) ? prev_sh : sh;
      float bs = pr[hf][0] + pr[hf][1] + pr[hf][2] + pr[hf][3] + add;
      prev_sh = sh;
      bs += __shfl_xor(bs, 1);
      bs += __shfl_xor(bs, 2);
      if ((lr & 3) == 0) imp[(4 * w + (lr >> 2)) * 64 + 4 * f + quad] = bs;
    }
  }
  sum += __shfl_xor(sum, 16);
  sum += __shfl_xor(sum, 32);
  const float inv = sum > 0.f ? 1.f / sum : 0.f;
  {
    const float g0 = inv * ((const float*)(ws + OFF_GATES))[((size_t)(b * SL + t)) * 24 + head * 3 + 0];
    u16* mp = (u16*)(ws + OFF_MIX) + ((size_t)(b * SL + t)) * 1024 + head * 64 + quad * 4;
#pragma unroll
    for (int df = 0; df < 4; df++) *(uint2*)(mp + df * 16) = pk4(g0 * O[df][0], g0 * O[df][1], g0 * O[df][2], g0 * O[df][3]);
  }
  __syncthreads();
  u64* selp = (u64*)(ws + OFF_SEL) + (size_t)bg * SL;
#pragma unroll 1
  for (int tl = 0; tl < 4; tl++) {
    const int tok = 4 * w + tl, tq = t0 + tok, cur = tq >> 6, j = lane;
    const float raw = imp[tok * 64 + j];
    const float INFV = __builtin_inff();
    const float v = (j <= cur) ? ((j == 0 || j == cur || j == cur - 1) ? INFV : raw) : -INFV;
    int rank = 0;
    const int vbits = __builtin_bit_cast(int, v);
#pragma unroll
    for (int jj = 0; jj < 64; jj++) {
      const float vv = __builtin_bit_cast(float, __builtin_amdgcn_readlane(vbits, jj));
      rank += ((vv > v) || (vv == v && jj < j)) ? 1 : 0;
    }
    const bool selb = (j <= cur) && rank < 16;
    const u64 mk = __ballot(selb);
    if (lane == 0) selp[tq] = mk;
  }
  __syncthreads();
}

struct FlashState { f32x4 O[2][4]; float m[2], l[2]; };

__device__ __forceinline__ void flash_block(FlashState& fs, const bf16x8 (&qf)[2][2], const unsigned char* lK, const unsigned char* lV,
                                            int kb, bool win, bool fast, const int (&tq)[2], const u64 (&msk)[2]) {
  const int lane = otid() & 63, lr = lane & 15, quad = lane >> 4;
  const int sw = (lr >> 1) & 7;
  const unsigned kbase = (unsigned)(size_t)lK + lr * 128;
  const unsigned ka0 = kbase + ((quad ^ sw) * 16), ka1 = kbase + (((4 + quad) ^ sw) * 16);
  bf16x8 kf[4][2];
  kf[0][0] = ldsr128<0>(ka0); kf[1][0] = ldsr128<2048>(ka0); kf[2][0] = ldsr128<4096>(ka0); kf[3][0] = ldsr128<6144>(ka0);
  kf[0][1] = ldsr128<0>(ka1); kf[1][1] = ldsr128<2048>(ka1); kf[2][1] = ldsr128<4096>(ka1); kf[3][1] = ldsr128<6144>(ka1);
  asm volatile("s_waitcnt lgkmcnt(0)"
               : "+v"(kf[0][0]), "+v"(kf[1][0]), "+v"(kf[2][0]), "+v"(kf[3][0]), "+v"(kf[0][1]), "+v"(kf[1][1]), "+v"(kf[2][1]), "+v"(kf[3][1]));
  f32x4 s[2][4];
  __builtin_amdgcn_s_setprio(1);
#pragma unroll
  for (int rg = 0; rg < 2; rg++)
#pragma unroll
    for (int f = 0; f < 4; f++) {
      s[rg][f] = mfma16(kf[f][0], qf[rg][0], f32x4{0.f, 0.f, 0.f, 0.f});
      s[rg][f] = mfma16(kf[f][1], qf[rg][1], s[rg][f]);
    }
  __builtin_amdgcn_s_setprio(0);
  const unsigned vbase = (unsigned)(size_t)lV + lr * 128 + (quad & 1) * 8;
  const unsigned va0 = vbase + (((quad >> 1)) ^ sw) * 16, va1 = vbase + ((2 + (quad >> 1)) ^ sw) * 16;
  const unsigned va2 = vbase + ((4 + (quad >> 1)) ^ sw) * 16, va3 = vbase + ((6 + (quad >> 1)) ^ sw) * 16;
  uint2 vl[4][2], vh[4][2];
  vl[0][0] = ldsr64<0>(va0); vh[0][0] = ldsr64<0>(va1); vl[0][1] = ldsr64<0>(va2); vh[0][1] = ldsr64<0>(va3);
  vl[1][0] = ldsr64<2048>(va0); vh[1][0] = ldsr64<2048>(va1); vl[1][1] = ldsr64<2048>(va2); vh[1][1] = ldsr64<2048>(va3);
  vl[2][0] = ldsr64<4096>(va0); vh[2][0] = ldsr64<4096>(va1); vl[2][1] = ldsr64<4096>(va2); vh[2][1] = ldsr64<4096>(va3);
  vl[3][0] = ldsr64<6144>(va0); vh[3][0] = ldsr64<6144>(va1); vl[3][1] = ldsr64<6144>(va2); vh[3][1] = ldsr64<6144>(va3);
  bf16x8 pf[2][2];
  bf16x8 vf[4][2];
#pragma unroll
  for (int rg = 0; rg < 2; rg++) {
    const int t = tq[rg];
    const bool rowok = win ? true : (((msk[rg] >> kb) & 1ull) != 0);
    const int tlo = win ? t - 511 : 0;
    float ps = 0.f;
    if (fast) {
#pragma unroll
      for (int f = 0; f < 4; f++)
#pragma unroll
        for (int j = 0; j < 4; j++) {
          const float pv = ex2(rowok ? s[rg][f][j] : -1000.f);
          s[rg][f][j] = pv;
          ps += pv;
        }
    } else {
#pragma unroll
      for (int f = 0; f < 4; f++)
#pragma unroll
        for (int j = 0; j < 4; j++) {
          const int key = kb * 64 + f * 16 + quad * 4 + j;
          const bool ok = rowok && (key <= t) && (key >= tlo);
          const float pv = ex2(ok ? s[rg][f][j] : -1000.f);
          s[rg][f][j] = pv;
          ps += pv;
        }
    }
    fs.l[rg] += ps;
#pragma unroll
    for (int gp = 0; gp < 2; gp++)
      pf[rg][gp] = mk8(pk4(s[rg][2 * gp][0], s[rg][2 * gp][1], s[rg][2 * gp][2], s[rg][2 * gp][3]),
                       pk4(s[rg][2 * gp + 1][0], s[rg][2 * gp + 1][1], s[rg][2 * gp + 1][2], s[rg][2 * gp + 1][3]));
    if (rg == 0) {
      asm volatile("s_waitcnt lgkmcnt(0)"
                   : "+v"(vl[0][0]), "+v"(vh[0][0]), "+v"(vl[0][1]), "+v"(vh[0][1]), "+v"(vl[1][0]), "+v"(vh[1][0]), "+v"(vl[1][1]), "+v"(vh[1][1]),
                     "+v"(vl[2][0]), "+v"(vh[2][0]), "+v"(vl[2][1]), "+v"(vh[2][1]), "+v"(vl[3][0]), "+v"(vh[3][0]), "+v"(vl[3][1]), "+v"(vh[3][1]));
#pragma unroll
      for (int df = 0; df < 4; df++)
#pragma unroll
        for (int gp = 0; gp < 2; gp++) vf[df][gp] = mk8(vl[df][gp], vh[df][gp]);
    }
    __builtin_amdgcn_s_setprio(1);
#pragma unroll
    for (int df = 0; df < 4; df++)
#pragma unroll
      for (int gp = 0; gp < 2; gp++) fs.O[rg][df] = mfma16(vf[df][gp], pf[rg][gp], fs.O[rg][df]);
    __builtin_amdgcn_s_setprio(0);
  }
}

__device__ __forceinline__ void flash_reset(FlashState& fs) {
#pragma unroll
  for (int rg = 0; rg < 2; rg++) {
    fs.m[rg] = NEGB; fs.l[rg] = 0.f;
#pragma unroll
    for (int df = 0; df < 4; df++) fs.O[rg][df] = f32x4{0.f, 0.f, 0.f, 0.f};
  }
}

__device__ __forceinline__ void flash_fold(FlashState& fs, const float* gates, int b, int head, const int (&tq)[2], int gi, uint2 (&pvv)[2][4]) {
#pragma unroll
  for (int rg = 0; rg < 2; rg++) {
    float lsum = fs.l[rg];
    lsum += __shfl_xor(lsum, 16);
    lsum += __shfl_xor(lsum, 32);
    const float gg = gates[((size_t)(b * SL + tq[rg])) * 24 + head * 3 + gi];
    const float sc = gg / lsum;
#pragma unroll
    for (int df = 0; df < 4; df++) {
      const uint2 pv = pvv[rg][df];
      const float c0 = bf2f((u16)(pv.x & 0xffff)), c1 = bf2f((u16)(pv.x >> 16)), c2 = bf2f((u16)(pv.y & 0xffff)), c3 = bf2f((u16)(pv.y >> 16));
      pvv[rg][df] = pk4(fs.O[rg][df][0] * sc + c0, fs.O[rg][df][1] * sc + c1, fs.O[rg][df][2] * sc + c2, fs.O[rg][df][3] * sc + c3);
    }
  }
}

__device__ void nsa_attn_item(const Params& p, int item, unsigned char* lds, volatile int* totx) {
  unsigned char* ws = p.ws;
  const int tid = otid(), lane = tid & 63, w = tid >> 6, lr = lane & 15, quad = lane >> 4;
  const int bg = item & 7, ti = item >> 3, t0 = ti * 32;
  const int b = bg >> 1, g = bg & 1, head = g * 4 + w;
  bf16x8 qf[2][2];
  int tq[2];
#pragma unroll
  for (int rg = 0; rg < 2; rg++) {
    tq[rg] = t0 + rg * 16 + lr;
    const u16* qp = (const u16*)(ws + OFF_Q) + ((size_t)(b * SL + tq[rg])) * 512 + head * 64 + quad * 8;
    qf[rg][0] = *(const bf16x8*)qp;
    qf[rg][1] = *(const bf16x8*)(qp + 32);
  }
  const u64* selp = (const u64*)(ws + OFF_SEL) + (size_t)bg * SL;
  u64 msk[2] = {selp[tq[0]], selp[tq[1]]};
  uint2 pvv[2][4];
#pragma unroll
  for (int rg = 0; rg < 2; rg++)
#pragma unroll
    for (int df = 0; df < 4; df++)
      pvv[rg][df] = *(const uint2*)((const u16*)(ws + OFF_MIX) + ((size_t)(b * SL + tq[rg])) * 1024 + head * 64 + quad * 4 + df * 16);
  unsigned ulo = (unsigned)(msk[0] | msk[1]), uhi = (unsigned)((msk[0] | msk[1]) >> 32);
#pragma unroll
  for (int o = 1; o < 16; o <<= 1) { ulo |= __shfl_xor(ulo, o); uhi |= __shfl_xor(uhi, o); }
  ulo = __builtin_amdgcn_readfirstlane(ulo);
  uhi = __builtin_amdgcn_readfirstlane(uhi);
  u64 un = ((u64)uhi << 32) | ulo;
  const int nsel = __builtin_popcountll(un);
  const int wlo = t0 - 511 > 0 ? (t0 - 511) >> 6 : 0;
  const int whi = (t0 + 31) >> 6;
  const int total = nsel + (whi - wlo + 1);
  const u16* Ks = (const u16*)(ws + OFF_KS) + (size_t)bg * SL * 64;
  const u16* Vs = (const u16*)(ws + OFF_VST) + (size_t)bg * 64 * SL;
  const u16* Kw = (const u16*)(ws + OFF_KW) + (size_t)bg * SL * 64;
  const u16* Vw = (const u16*)(ws + OFF_VWT) + (size_t)bg * 64 * SL;
  const int drow = tid >> 3, dlc = (tid & 7) ^ ((drow >> 1) & 7);
#define ATT_ISSUE(stage, Kp, Vp, kb_)                                                                                  \
  do {                                                                                                                 \
    _Pragma("unroll") for (int i_ = 0; i_ < 2; i_++) {                                                                 \
      __builtin_amdgcn_global_load_lds((const unsigned*)((Kp) + ((size_t)((kb_) * 64 + drow + 32 * i_)) * 64 + dlc * 8), \
                                       (unsigned*)(lds + (stage) * 16384 + (tid + 256 * i_) * 16), 16, 0, 0);          \
      __builtin_amdgcn_global_load_lds((const unsigned*)((Vp) + (size_t)(drow + 32 * i_) * SL + (kb_) * 64 + dlc * 8), \
                                       (unsigned*)(lds + (stage) * 16384 + 8192 + (tid + 256 * i_) * 16), 16, 0, 0);   \
    }                                                                                                                  \
  } while (0)
  const int npairs = (total + 1) >> 1;
  {
    const int half_ = ohalf();
    if (tid == 0) totx[half_] = npairs;
    __syncthreads();
  }
  const int tmaxb = totx[0] > totx[1] ? totx[0] : totx[1];
  FlashState fs;
  const float* gp_ = (const float*)(ws + OFF_GATES);
  flash_reset(fs);
  u64 rem_i = un;
  int ii = 0;
#define ATT_ISSUE_NEXT(slot)                                                                 \
  do {                                                                                       \
    if (ii < total) {                                                                        \
      if (ii < nsel) { const int kb_ = __builtin_ctzll(rem_i); rem_i &= rem_i - 1; ATT_ISSUE(slot, Ks, Vs, kb_); } \
      else { const int kb_ = wlo + (ii - nsel); ATT_ISSUE(slot, Kw, Vw, kb_); }              \
      ii++;                                                                                  \
    }                                                                                        \
  } while (0)
  ATT_ISSUE_NEXT(0);
  ATT_ISSUE_NEXT(1);
  u64 rem_c = un;
#pragma unroll 1
  for (int pi = 0; pi < tmaxb; pi++) {
    asm volatile("s_waitcnt vmcnt(0)" ::: "memory");
    __builtin_amdgcn_s_barrier();
    __builtin_amdgcn_sched_barrier(0);
    if (pi >= npairs) continue;
    const int sbase = (pi & 1) * 2;
    ATT_ISSUE_NEXT((sbase ^ 2));
    ATT_ISSUE_NEXT((sbase ^ 2) + 1);
#pragma unroll 1
    for (int sub = 0; sub < 2; sub++) {
      const int i = 2 * pi + sub;
      if (i >= total) break;
      int kb_cur;
      if (i < nsel) { kb_cur = __builtin_ctzll(rem_c); rem_c &= rem_c - 1; }
      else kb_cur = wlo + (i - nsel);
      if (i == nsel) {
        flash_fold(fs, gp_, b, head, tq, 1, pvv);
        flash_reset(fs);
      }
      const unsigned char* lK = lds + (sbase + sub) * 16384;
      const bool winb = i >= nsel;
      const bool fast = winb ? ((kb_cur * 64 >= t0 + 31 - 511) && (kb_cur * 64 + 63 <= t0)) : (kb_cur < (t0 >> 6));
      flash_block(fs, qf, lK, lK + 8192, kb_cur, winb, fast, tq, msk);
    }
  }
#undef ATT_ISSUE_NEXT
  flash_fold(fs, gp_, b, head, tq, 2, pvv);
#pragma unroll
  for (int rg = 0; rg < 2; rg++)
#pragma unroll
    for (int df = 0; df < 4; df++)
      *(uint2*)((u16*)(ws + OFF_MIX) + ((size_t)(b * SL + tq[rg])) * 1024 + head * 64 + quad * 4 + df * 16) = pvv[rg][df];
  __syncthreads();
#undef ATT_ISSUE
}

__device__ void hgrn_u_item(const Params& p, int item) {
  unsigned char* ws = p.ws;
  const int tid_ = otid(); const int lane = tid_ & 63, w = tid_ >> 6, lr = lane & 15, quad = lane >> 4;
  const int bh = item >> 6, c = item & 63, b = bh >> 2, h = bh & 3;
  const size_t tokb = (size_t)b * SL + c * 64;
  const u16* ktT = (const u16*)(ws + OFF_KTT);
  const u16* vhT = (const u16*)(ws + OFF_VHT);
  f32x4 acc[2][8];
#pragma unroll
  for (int i = 0; i < 2; i++)
#pragma unroll
    for (int d = 0; d < 8; d++) acc[i][d] = f32x4{0.f, 0.f, 0.f, 0.f};
#pragma unroll
  for (int ks = 0; ks < 2; ks++) {
    bf16x8 a[2];
#pragma unroll
    for (int i = 0; i < 2; i++) a[i] = *(const bf16x8*)(ktT + (size_t)(h * 128 + (2 * w + i) * 16 + lr) * MT + tokb + ks * 32 + quad * 8);
#pragma unroll
    for (int d = 0; d < 8; d++) {
      const bf16x8 bv = *(const bf16x8*)(vhT + (size_t)(h * 128 + d * 16 + lr) * MT + tokb + ks * 32 + quad * 8);
#pragma unroll
      for (int i = 0; i < 2; i++) acc[i][d] = mfma16(a[i], bv, acc[i][d]);
    }
  }
  u16* US = (u16*)p.out;
#pragma unroll
  for (int i = 0; i < 2; i++)
#pragma unroll
    for (int d = 0; d < 8; d++)
      *(uint2*)(US + ((size_t)(bh * 64 + c) * 128 + d * 16 + lr) * 128 + (2 * w + i) * 16 + quad * 4) =
          pk4(acc[i][d][0], acc[i][d][1], acc[i][d][2], acc[i][d][3]);
}

__device__ void hgrn_scan_item(const Params& p, int item) {
  unsigned char* ws = p.ws;
  const int gidx = item * 256 + otid();
  const int bh = gidx >> 13, dv = (gidx >> 6) & 127, dk = (gidx & 63) * 2, b = bh >> 2, h = bh & 3;
  unsigned* up = (unsigned*)((u16*)p.out + ((size_t)bh * 64 * 128 + dv) * 128 + dk);
  const size_t foff = (size_t)(b * 64) * 512 + h * 128 + dk;
  const float* pem = (const float*)(ws + OFF_CVEM) + foff;
  const float* pdl = (const float*)(ws + OFF_CVDL) + foff;
  const float* pe1 = (const float*)(ws + OFF_CVE1) + foff;
  float S0 = 0.f, S1 = 0.f;
  unsigned ua[8], ub[8];
  float2 ema[8], dla[8], e1a[8], emb[8], dlb[8], e1b[8];
#pragma unroll
  for (int i = 0; i < 8; i++) {
    ua[i] = up[(size_t)i * 8192];
    ema[i] = *(const float2*)(pem + i * 512); dla[i] = *(const float2*)(pdl + i * 512); e1a[i] = *(const float2*)(pe1 + i * 512);
  }
#pragma unroll 1
  for (int g = 0; g < 8; g++) {
    if (g < 7) {
#pragma unroll
      for (int i = 0; i < 8; i++) {
        const int c = (g + 1) * 8 + i;
        ub[i] = up[(size_t)c * 8192];
        emb[i] = *(const float2*)(pem + c * 512); dlb[i] = *(const float2*)(pdl + c * 512); e1b[i] = *(const float2*)(pe1 + c * 512);
      }
    }
#pragma unroll
    for (int i = 0; i < 8; i++) {
      const int c = g * 8 + i;
      const float u0 = bf2f((u16)(ua[i] & 0xffff)), u1 = bf2f((u16)(ua[i] >> 16));
      up[(size_t)c * 8192] = pk2(ema[i].x * S0, ema[i].y * S1);
      S0 = dla[i].x * S0 + e1a[i].x * u0;
      S1 = dla[i].y * S1 + e1a[i].y * u1;
    }
#pragma unroll
    for (int i = 0; i < 8; i++) { ua[i] = ub[i]; ema[i] = emb[i]; dla[i] = dlb[i]; e1a[i] = e1b[i]; }
  }
}

__device__ void hgrn_out_item(const Params& p, int l, int item, u16* lds) {
  unsigned char* ws = p.ws;
  const int tid = otid(), lane = tid & 63, w = tid >> 6, lr = lane & 15, quad = lane >> 4;
  const int bh = item >> 6, c = item & 63, b = bh >> 2, h = bh & 3;
  const size_t tokb = (size_t)b * SL + c * 64;
  const u16* qtT = (const u16*)(ws + OFF_QTT);
  const u16* ktT = (const u16*)(ws + OFF_KTT);
  u16* lq = lds;
  u16* lk = lds + 128 * 66;
  uint4 vqa[4], vka[4];
#pragma unroll
  for (int i = 0; i < 4; i++) {
    const int cid = tid + 256 * i, row = cid >> 3, c8 = (cid & 7) * 8;
    vqa[i] = *(const uint4*)(qtT + (size_t)(h * 128 + row) * MT + tokb + c8);
    vka[i] = *(const uint4*)(ktT + (size_t)(h * 128 + row) * MT + tokb + c8);
  }
#pragma unroll
  for (int i = 0; i < 4; i++) {
    const int cid = tid + 256 * i, row = cid >> 3, c8 = (cid & 7) * 8;
    unsigned* dq = (unsigned*)(lq + row * 66 + c8);
    unsigned* dk = (unsigned*)(lk + row * 66 + c8);
    dq[0] = vqa[i].x; dq[1] = vqa[i].y; dq[2] = vqa[i].z; dq[3] = vqa[i].w;
    dk[0] = vka[i].x; dk[1] = vka[i].y; dk[2] = vka[i].z; dk[3] = vka[i].w;
  }
  __syncthreads();
  bf16x8 qB[4];
#pragma unroll
  for (int ks = 0; ks < 4; ks++) {
    bf16x8 v;
#pragma unroll
    for (int i = 0; i < 8; i++) v[i] = (short)lq[(ks * 32 + quad * 8 + i) * 66 + 16 * w + lr];
    qB[ks] = v;
  }
  f32x4 D1[4];
#pragma unroll
  for (int sf = 0; sf < 4; sf++) {
    D1[sf] = f32x4{0.f, 0.f, 0.f, 0.f};
    if (sf <= w) {
#pragma unroll
      for (int ks = 0; ks < 4; ks++) {
        bf16x8 v;
#pragma unroll
        for (int i = 0; i < 8; i++) v[i] = (short)lk[(ks * 32 + quad * 8 + i) * 66 + sf * 16 + lr];
        D1[sf] = mfma16(v, qB[ks], D1[sf]);
      }
    }
    const int tt = 16 * w + lr;
#pragma unroll
    for (int j = 0; j < 4; j++) {
      const int s_ = sf * 16 + quad * 4 + j;
      if (s_ > tt) D1[sf][j] = 0.f;
    }
  }
  bf16x8 pB[2];
#pragma unroll
  for (int gp = 0; gp < 2; gp++)
    pB[gp] = mk8(pk4(D1[2 * gp][0], D1[2 * gp][1], D1[2 * gp][2], D1[2 * gp][3]),
                 pk4(D1[2 * gp + 1][0], D1[2 * gp + 1][1], D1[2 * gp + 1][2], D1[2 * gp + 1][3]));
  const u16* vhT = (const u16*)(ws + OFF_VHT);
  const u16* US = (const u16*)p.out;
  f32x4 o[8];
#pragma unroll
  for (int d = 0; d < 8; d++) {
    o[d] = f32x4{0.f, 0.f, 0.f, 0.f};
    const u16* vp = vhT + (size_t)(h * 128 + d * 16 + lr) * MT + tokb + quad * 4;
#pragma unroll
    for (int gp = 0; gp < 2; gp++) {
      if (gp * 2 <= w) {
        const bf16x8 vf = mk8(*(const uint2*)(vp + gp * 32), *(const uint2*)(vp + gp * 32 + 16));
        o[d] = mfma16(vf, pB[gp], o[d]);
      }
    }
    const u16* sp = US + ((size_t)(bh * 64 + c) * 128 + d * 16 + lr) * 128 + quad * 8;
#pragma unroll
    for (int ks = 0; ks < 4; ks++) o[d] = mfma16(*(const bf16x8*)(sp + ks * 32), qB[ks], o[d]);
    if (d & 1) __builtin_amdgcn_sched_barrier(0);
  }
  float ss = 0.f;
#pragma unroll
  for (int d = 0; d < 8; d++)
#pragma unroll
    for (int j = 0; j < 4; j++) ss += o[d][j] * o[d][j];
  ss += __shfl_xor(ss, 16);
  ss += __shfl_xor(ss, 32);
  const float r = rsqrtf(ss * (1.f / 128.f) + EPSV);
  const size_t m = tokb + 16 * w + lr;
  const u16* hgp = (const u16*)(ws + OFF_HG) + m * 512 + h * 128 + quad * 4;
  const float* og = p.out_norm + l * 128 + quad * 4;
  u16* mp = (u16*)(ws + OFF_MIX) + m * 1024 + 512 + h * 128 + quad * 4;
  uint2 hvv[8];
#pragma unroll
  for (int d = 0; d < 8; d++) hvv[d] = *(const uint2*)(hgp + d * 16);
#pragma unroll
  for (int d = 0; d < 8; d++) {
    const uint2 hv = hvv[d];
    const float4 g4 = *(const float4*)(og + d * 16);
    const float h0 = bf2f((u16)(hv.x & 0xffff)), h1 = bf2f((u16)(hv.x >> 16)), h2 = bf2f((u16)(hv.y & 0xffff)), h3 = bf2f((u16)(hv.y >> 16));
    *(uint2*)(mp + d * 16) = pk4(o[d][0] * r * g4.x * siluf_(h0), o[d][1] * r * g4.y * siluf_(h1),
                                 o[d][2] * r * g4.z * siluf_(h2), o[d][3] * r * g4.w * siluf_(h3));
  }
  __syncthreads();
}

__global__ void __launch_bounds__(512, 2) fwd_mega(Params p) {
  __shared__ __attribute__((aligned(16))) unsigned char smem[2 * 73728 + 1024];
  __shared__ unsigned xbst[2];
  __shared__ int totx[2];
  unsigned char* ws = p.ws;
  XcdBarrier gb;
  gb.bar = (unsigned*)(ws + OFF_CTL); gb.x = xb_xcc_id(); gb.st = xbst;
  if (threadIdx.x == 0) { xbst[0] = 0u; xbst[1] = 0u; (void)xb_add(&gb.bar[XB_XCNT(gb.x)], 1u); }
  __syncthreads();
  if (p.never) cg::this_grid().sync();
  const int half = ohalf();
  const int G = gridDim.x * 2, bid = blockIdx.x * 2 + half;
  unsigned char* hsm = smem + half * 73728;
  float* rowss = (float*)(ws + OFF_ROWSS);
  u16* xb = (u16*)(ws + OFF_XB);
  u16* Hb = (u16*)(ws + OFF_H);
  u16* mix = (u16*)(ws + OFF_MIX);

  phase_init(p);
#pragma unroll 1
  for (int l = 0; l < 2; l++) {
    phase_convert(p, l, (float*)smem);
    grid_bar(gb);
    phase_gemm(p, l, G_UP, xb, DM, (const u16*)(ws + OFF_WGU1), DM, DM, 22, rowss + (size_t)(3 * l) * MT * 16, nullptr, 0.f, Hb, (u16*)smem);
    grid_bar(gb);
    phase_gemm(p, l, G_DOWN, Hb, DFF, (const u16*)(ws + OFF_WD1), DFF, DFF, 4, nullptr, rowss + (size_t)(3 * l + 1) * MT * 16, 0.5f, nullptr, (u16*)smem);
    grid_bar(gb);
    phase_gemm(p, l, G_INPROJ, xb, DM, (const u16*)(ws + OFF_WIN), DM, DM, 14, rowss + (size_t)(3 * l + 1) * MT * 16, nullptr, 0.f, nullptr, (u16*)smem);
    grid_bar(gb);
    if (bid < 256) {
      compress_item(p, bid, (u16*)hsm);
      hgrn_u_item(p, bid);
    } else {
#pragma unroll 1
      for (int k = 0; k < 3; k++) hgrn_u_item(p, 256 + (bid - 256) * 3 + k);
    }
    grid_bar(gb);
    {
      const int bgc = bid >> 6;
      cmpattn_stage(p, bgc, hsm);
#pragma unroll 1
      for (int k = 0; k < 4; k++) cmpattn_item(p, bgc, (bid & 63) + 64 * k, hsm, (float*)(hsm + 65536));
      hgrn_scan_item(p, bid);
    }
    grid_bar(gb);
    for (int pass = 0;; pass++) {
      const int base = pass * G;
      if (base >= 1024) break;
      const int it = (pass & 1) ? (base + G - 1 - bid) : (base + bid);
      nsa_attn_item(p, it, hsm, totx);
    }
    for (int it = bid; it < 1024; it += G) hgrn_out_item(p, l, it, (u16*)hsm);
    grid_bar(gb);
    phase_gemm(p, l, G_DOWN, mix, DM, (const u16*)(ws + OFF_WOUT), DM, DM, 4, nullptr, rowss + (size_t)(3 * l + 2) * MT * 16, 1.0f, nullptr, (u16*)smem);
    grid_bar(gb);
    phase_gemm(p, l, G_UP, xb, DM, (const u16*)(ws + OFF_WGU2), DM, DM, 22, rowss + (size_t)(3 * l + 2) * MT * 16, nullptr, 0.f, Hb, (u16*)smem);
    grid_bar(gb);
    phase_gemm(p, l, G_DOWN, Hb, DFF, (const u16*)(ws + OFF_WD2), DFF, DFF, 4, nullptr, rowss + (size_t)(3 * l + 3) * MT * 16, 0.5f, nullptr, (u16*)smem, l == 1);
    grid_bar(gb);
  }
}

extern "C" void kernel_launch(void* const* d_in, const int* in_sizes, int n_in, void* d_out, int out_size, void* d_ws,
                              size_t ws_size, hipStream_t stream) {
  static int grid_blocks = 0;
  if (!grid_blocks) {
    int dev = 0, cus = 0, per_cu = 0;
    hipGetDevice(&dev);
    hipDeviceGetAttribute(&cus, hipDeviceAttributeMultiprocessorCount, dev);
    hipOccupancyMaxActiveBlocksPerMultiprocessor(&per_cu, fwd_mega, 512, 0);
    if (per_cu > 1) per_cu = 1;
    if (per_cu < 1) per_cu = 1;
    grid_blocks = cus * per_cu;
    grid_blocks -= grid_blocks % 8;
  }
  Params p{};
  const float* const* in = (const float* const*)d_in;
  p.x = in[0]; p.ffn1_norm = in[1]; p.ffn1_wg = in[2]; p.ffn1_wu = in[3]; p.ffn1_wd = in[4]; p.mix_norm = in[5];
  p.w_in = in[6]; p.q_norm = in[7]; p.k_norm = in[8]; p.cmp_pos = in[9]; p.cmp_w1 = in[10]; p.cmp_w2 = in[11];
  p.lb_logits = in[12]; p.out_norm = in[13]; p.w_out = in[14]; p.ffn2_norm = in[15]; p.ffn2_wg = in[16];
  p.ffn2_wu = in[17]; p.ffn2_wd = in[18];
  p.out = (float*)d_out;
  p.ws = (unsigned char*)d_ws;
  p.never = 0;
  p.pad = 0;
  hipMemsetAsync(d_ws, 0, 16384, stream);
  void* args[] = {&p};
  hipError_t e = hipLaunchCooperativeKernel((void*)fwd_mega, dim3(grid_blocks), dim3(512), args, 0, stream);
  if (e != hipSuccess) fprintf(stderr, "cooperative launch failed: %s (grid %d)\n", hipGetErrorString(e), grid_blocks);
}
```
